# Optimizing an MI355X kernel written in HIP

```python
import jax, jax.numpy as jnp
from jax import lax
import numpy as np

D_MODEL = 2048
BATCH = 2
SEQ = 8192
DEPTH = 4

PLE_DIM = 256
D_FF = 5504
EPS = 1e-6
NEG_INF = -1e30
N_BRANCH = 4
BRANCH_WIDTH = 1024

RNN_WIDTH = 1024
RNN_HEADS = 16
RNN_HEAD_DIM = RNN_WIDTH // RNN_HEADS
CONV_WIDTH = 4
RG_C = 8.0

POOL_WIDTH = 1024
POOL_WINDOWS = (2, 4, 8, 16)
POOL_GROUP = POOL_WIDTH // len(POOL_WINDOWS)

HEAD_DIM = 128
KV_HEADS = 8
ATTN_PATTERNS = ((128, 1), (512, 4), (2048, 16))
N_GROUPS_C = len(ATTN_PATTERNS)
Q_HEADS = KV_HEADS * N_GROUPS_C
ATTN_BLOCK = 128
ATTN_WIDTH = KV_HEADS * HEAD_DIM

SG_WIDTH = 1024
SG_CHUNK = 128
SG_GROUPS = 8
SG_GROUP_DIM = SG_WIDTH // SG_GROUPS

IN_WIDTHS = (RNN_WIDTH, RNN_WIDTH, POOL_WIDTH, Q_HEADS * HEAD_DIM, ATTN_WIDTH, ATTN_WIDTH,
             2 * SG_WIDTH, N_BRANCH * D_MODEL)
IN_COLS = sum(IN_WIDTHS)

kernel_name = "hybrid_parallel_gated_trunk"


def rms_norm(x, g):
    xf = x.astype(jnp.float32)
    y = xf * lax.rsqrt(jnp.mean(xf * xf, axis=-1, keepdims=True) + EPS)
    return (y * g.astype(jnp.float32)).astype(x.dtype)


def swiglu(h, w1, w3, w2):
    return (jax.nn.silu(h @ w1) * (h @ w3)) @ w2


def causal_depthwise_conv(x, w, b):
    S = x.shape[1]
    xp = jnp.pad(x, ((0, 0), (CONV_WIDTH - 1, 0), (0, 0)))
    y = b
    for j in range(CONV_WIDTH):
        y = y + w[j] * xp[:, CONV_WIDTH - 1 - j: CONV_WIDTH - 1 - j + S]
    return y


def rg_lru(x, wa, ba, wx, bx, lam):
    B, S, _ = x.shape
    xh = x.reshape(B, S, RNN_HEADS, RNN_HEAD_DIM)
    r = jax.nn.sigmoid(jnp.einsum('bshi,hij->bshj', xh, wa).reshape(B, S, RNN_WIDTH) + ba)
    i_g = jax.nn.sigmoid(jnp.einsum('bshi,hij->bshj', xh, wx).reshape(B, S, RNN_WIDTH) + bx)
    log_a = (-RG_C * r.astype(jnp.float32)) * jax.nn.softplus(-lam.astype(jnp.float32))
    a = jnp.exp(log_a)
    mult = jnp.sqrt(-jnp.expm1(2.0 * log_a))
    u = mult * (i_g * x).astype(jnp.float32)

    def combine(c1, c2):
        a1, b1 = c1
        a2, b2 = c2
        return a1 * a2, a2 * b1 + b2

    _, h = lax.associative_scan(combine, (a, u), axis=1)
    return h.astype(x.dtype)


def multi_scale_pool(x, w_pool, scale):
    B, S, _ = x.shape
    xg = x.reshape(B, S, len(POOL_WINDOWS), POOL_GROUP).astype(jnp.float32)
    csum = jnp.cumsum(xg, axis=1)
    pos = jnp.arange(S)
    outs = []
    for g, win in enumerate(POOL_WINDOWS):
        c = csum[:, :, g]
        shifted = jnp.pad(c, ((0, 0), (win, 0), (0, 0)))[:, :S]
        cnt = jnp.minimum(pos + 1, win).astype(jnp.float32)[None, :, None]
        outs.append((c - shifted) / cnt - xg[:, :, g])
    pooled = jnp.stack(outs, axis=2)
    y = jnp.einsum('bsgc,gcd->bsgd', pooled, w_pool.astype(jnp.float32)).reshape(B, S, POOL_WIDTH)
    return (y * scale.astype(jnp.float32)).astype(x.dtype)


def dilated_window_attention(q, k, v, window, dilation):
    B, S, H, D = q.shape
    n_back = window // dilation
    assert n_back <= ATTN_BLOCK
    span = dilation * ATTN_BLOCK
    S_pad = -(-S // span) * span
    L = S_pad // dilation
    nb = L // ATTN_BLOCK
    pad = ((0, 0), (0, S_pad - S), (0, 0), (0, 0))

    def to_blocks(t):
        t = jnp.pad(t, pad).reshape(B, L, dilation, H, D).transpose(0, 2, 1, 3, 4)
        return t.reshape(B, dilation, nb, ATTN_BLOCK, H, D)

    def band(t):
        prev = jnp.pad(t, ((0, 0), (0, 0), (1, 0), (0, 0), (0, 0), (0, 0)))[:, :, :-1]
        return jnp.concatenate([prev, t], axis=3)

    qb = to_blocks(q)
    kband = band(to_blocks(k))
    vband = band(to_blocks(v))
    s = jnp.einsum('brnqhd,brnkhd->brnhqk', qb, kband) * (D ** -0.5)
    qi = jnp.arange(ATTN_BLOCK)[:, None] + ATTN_BLOCK
    ki = jnp.arange(2 * ATTN_BLOCK)[None, :]
    dist = qi - ki
    key_pos = jnp.arange(nb)[:, None] * ATTN_BLOCK + ki - ATTN_BLOCK
    mask = ((dist >= 0) & (dist <= n_back))[None] & (key_pos >= 0)[:, None, :]
    s = jnp.where(mask[None, None, :, None], s, NEG_INF)
    m = jnp.max(s, axis=-1, keepdims=True)
    pexp = jnp.exp(s - m)
    denom = jnp.sum(pexp, axis=-1, keepdims=True)
    o = jnp.einsum('brnhqk,brnkhd->brnqhd', pexp, vband) / denom.transpose(0, 1, 2, 4, 3, 5)
    lse = (m + jnp.log(denom))[..., 0].transpose(0, 1, 2, 4, 3)
    o = o.reshape(B, dilation, L, H, D).transpose(0, 2, 1, 3, 4).reshape(B, S_pad, H, D)[:, :S]
    lse = lse.reshape(B, dilation, L, H).transpose(0, 2, 1, 3).reshape(B, S_pad, H)[:, :S]
    return o, lse


def spatial_gating(z, norm_g, w_s, b_s):
    u, vv = jnp.split(z, 2, axis=-1)
    vv = rms_norm(vv, norm_g)
    B, S, _ = vv.shape
    nc = S // SG_CHUNK
    vc = vv.reshape(B, nc, SG_CHUNK, SG_GROUPS, SG_GROUP_DIM)
    tri = jnp.tril(jnp.ones((SG_CHUNK, SG_CHUNK), dtype=bool))
    ws = jnp.where(tri[None], w_s, 0.0)
    mixed = jnp.einsum('gts,bnsgc->bntgc', ws, vc) + b_s.T[None, None, :, :, None]
    return u * mixed.reshape(B, S, SG_WIDTH)


def setup_inputs(seed: int = 0) -> dict:
    key = jax.random.key(seed)
    ks = iter(jax.random.split(key, 40))

    def nrm(shape, scale):
        return jax.random.normal(next(ks), shape, jnp.float32) * scale

    def gain(shape, s=0.02):
        return 1.0 + nrm(shape, s)

    L, D, F = DEPTH, D_MODEL, D_FF
    x = nrm((BATCH, SEQ, D), 1.0)
    p = nrm((L, BATCH, SEQ, PLE_DIM), 1.0)
    ffn1_norm = gain((L, D))
    ffn1_w1 = nrm((L, D, F), D ** -0.5)
    ffn1_w3 = nrm((L, D, F), D ** -0.5)
    ffn1_w2 = nrm((L, F, D), F ** -0.5)
    mix_norm = gain((L, D))
    w_in = nrm((L, D, IN_COLS), D ** -0.5)
    b_gate = nrm((L, N_BRANCH, D), 0.02)
    conv_w = nrm((L, CONV_WIDTH, RNN_WIDTH), CONV_WIDTH ** -0.5)
    conv_b = nrm((L, RNN_WIDTH), 0.02)
    rg_wa = nrm((L, RNN_HEADS, RNN_HEAD_DIM, RNN_HEAD_DIM), RNN_HEAD_DIM ** -0.5)
    rg_ba = nrm((L, RNN_WIDTH), 0.02)
    rg_wx = nrm((L, RNN_HEADS, RNN_HEAD_DIM, RNN_HEAD_DIM), RNN_HEAD_DIM ** -0.5)
    rg_bx = nrm((L, RNN_WIDTH), 0.02)
    a0 = jax.random.uniform(next(ks), (L, RNN_WIDTH), jnp.float32, 0.9, 0.999)
    rg_lambda = jnp.log(a0) - jnp.log1p(-a0)
    pool_w = nrm((L, len(POOL_WINDOWS), POOL_GROUP, POOL_GROUP), POOL_GROUP ** -0.5)
    pool_scale = gain((L, POOL_WIDTH), 0.1)
    q_gain = gain((L, HEAD_DIM))
    k_gain = gain((L, HEAD_DIM))
    sg_norm = gain((L, SG_WIDTH))
    sg_w = nrm((L, SG_GROUPS, SG_CHUNK, SG_CHUNK), SG_CHUNK ** -0.5)
    sg_b = gain((L, SG_GROUPS, SG_CHUNK))
    w_branch = nrm((L, N_BRANCH, BRANCH_WIDTH, D), BRANCH_WIDTH ** -0.5)
    w_out = nrm((L, D, D), D ** -0.5)
    ffn2_norm = gain((L, D))
    ffn2_w1 = nrm((L, D, F), D ** -0.5)
    ffn2_w3 = nrm((L, D, F), D ** -0.5)
    ffn2_w2 = nrm((L, F, D), F ** -0.5)
    ple_norm = gain((L, D))
    ple_gate_w = nrm((L, D, D), D ** -0.5)
    ple_proj = nrm((L, PLE_DIM, D), PLE_DIM ** -0.5)
    return {"x": x, "p": p, "ffn1_norm": ffn1_norm, "ffn1_w1": ffn1_w1, "ffn1_w3": ffn1_w3,
            "ffn1_w2": ffn1_w2, "mix_norm": mix_norm, "w_in": w_in, "b_gate": b_gate,
            "conv_w": conv_w, "conv_b": conv_b, "rg_wa": rg_wa, "rg_ba": rg_ba, "rg_wx": rg_wx,
            "rg_bx": rg_bx, "rg_lambda": rg_lambda, "pool_w": pool_w, "pool_scale": pool_scale,
            "q_gain": q_gain, "k_gain": k_gain, "sg_norm": sg_norm, "sg_w": sg_w, "sg_b": sg_b,
            "w_branch": w_branch, "w_out": w_out, "ffn2_norm": ffn2_norm, "ffn2_w1": ffn2_w1,
            "ffn2_w3": ffn2_w3, "ffn2_w2": ffn2_w2, "ple_norm": ple_norm, "ple_gate_w": ple_gate_w,
            "ple_proj": ple_proj}


def reference(x, p, ffn1_norm, ffn1_w1, ffn1_w3, ffn1_w2, mix_norm, w_in, b_gate, conv_w, conv_b,
              rg_wa, rg_ba, rg_wx, rg_bx, rg_lambda, pool_w, pool_scale, q_gain, k_gain, sg_norm,
              sg_w, sg_b, w_branch, w_out, ffn2_norm, ffn2_w1, ffn2_w3, ffn2_w2, ple_norm,
              ple_gate_w, ple_proj):
    B, S, _ = x.shape
    split_idx = np.cumsum(IN_WIDTHS)[:-1].tolist()
    for i in range(DEPTH):
        x = x + 0.5 * swiglu(rms_norm(x, ffn1_norm[i]), ffn1_w1[i], ffn1_w3[i], ffn1_w2[i])

        h = rms_norm(x, mix_norm[i])
        proj = h @ w_in[i]
        xa, ga, xb, qf, kf, vf, zd, gates = jnp.split(proj, split_idx, axis=-1)

        ya = rg_lru(causal_depthwise_conv(xa, conv_w[i], conv_b[i]),
                    rg_wa[i], rg_ba[i], rg_wx[i], rg_bx[i], rg_lambda[i]) * jax.nn.gelu(ga)

        yb = multi_scale_pool(xb, pool_w[i], pool_scale[i])

        q = rms_norm(qf.reshape(B, S, Q_HEADS, HEAD_DIM), q_gain[i]).astype(jnp.float32)
        q = q.reshape(B, S, N_GROUPS_C, KV_HEADS, HEAD_DIM)
        k = rms_norm(kf.reshape(B, S, KV_HEADS, HEAD_DIM), k_gain[i]).astype(jnp.float32)
        v = vf.reshape(B, S, KV_HEADS, HEAD_DIM).astype(jnp.float32)
        outs, lses = [], []
        for g, (win, dil) in enumerate(ATTN_PATTERNS):
            o, l = dilated_window_attention(q[:, :, g], k, v, win, dil)
            outs.append(o)
            lses.append(l)
        wg = jax.nn.softmax(jnp.stack(lses, axis=0), axis=0)[..., None]
        yc = jnp.sum(wg * jnp.stack(outs, axis=0), axis=0).reshape(B, S, ATTN_WIDTH).astype(x.dtype)

        yd = spatial_gating(jax.nn.gelu(zd), sg_norm[i], sg_w[i], sg_b[i])

        gate = jax.nn.sigmoid(gates.reshape(B, S, N_BRANCH, D_MODEL) + b_gate[i])
        merged = gate[:, :, 0] * (ya @ w_branch[i, 0])
        merged = merged + gate[:, :, 1] * (yb @ w_branch[i, 1])
        merged = merged + gate[:, :, 2] * (yc @ w_branch[i, 2])
        merged = merged + gate[:, :, 3] * (yd @ w_branch[i, 3])
        x = x + merged @ w_out[i]

        x = x + 0.5 * swiglu(rms_norm(x, ffn2_norm[i]), ffn2_w1[i], ffn2_w3[i], ffn2_w2[i])

        pg = jax.nn.sigmoid(rms_norm(x, ple_norm[i]) @ ple_gate_w[i])
        x = x + pg * (p[i] @ ple_proj[i])
    return x
```

```cpp
#include <hip/hip_runtime.h>
#include <cstdio>
#include <cstdint>

#define LAS __attribute__((address_space(3)))
#define GAS __attribute__((address_space(1)))
typedef unsigned short bf16_t;
typedef short bf16x8 __attribute__((ext_vector_type(8)));
typedef float f32x4 __attribute__((ext_vector_type(4)));
typedef float f32x2 __attribute__((ext_vector_type(2)));
typedef unsigned u32x4 __attribute__((ext_vector_type(4)));
typedef unsigned u32x2 __attribute__((ext_vector_type(2)));

constexpr int M = 16384, SEQ = 8192, D = 2048, F = 5504, NL = 4, PLE = 256, NIN = 18432;
constexpr int C_XA = 0, C_GA = 1024, C_XB = 2048, C_Q = 3072, C_K = 6144, C_V = 7168, C_ZU = 8192, C_ZV = 9216, C_GATE = 10240;
constexpr float EPS = 1e-6f;
constexpr int NWAVES = 8, NTHR = 512;

__device__ __forceinline__ unsigned f2bf(float f) { unsigned u = __builtin_bit_cast(unsigned, f); return (u + 0x7fffu + ((u >> 16) & 1u)) >> 16; }
__device__ __forceinline__ unsigned pk2(float lo, float hi) { return f2bf(lo) | (f2bf(hi) << 16); }
__device__ __forceinline__ float bf2f(unsigned short b) { return __builtin_bit_cast(float, ((unsigned)b) << 16); }
__device__ __forceinline__ float bflo(unsigned w) { return __builtin_bit_cast(float, w << 16); }
__device__ __forceinline__ float bfhi(unsigned w) { return __builtin_bit_cast(float, w & 0xffff0000u); }
__device__ __forceinline__ unsigned cvt_pk_bf16(float lo, float hi) { unsigned r; asm volatile("v_cvt_pk_bf16_f32 %0, %1, %2" : "=v"(r) : "v"(lo), "v"(hi)); return r; }
__device__ __forceinline__ float wave_sum(float v) {
#pragma unroll
    for (int o = 1; o < 64; o <<= 1) v += __shfl_xor(v, o);
    return v;
}
__device__ __forceinline__ float wave_max(float v) {
#pragma unroll
    for (int o = 1; o < 64; o <<= 1) v = fmaxf(v, __shfl_xor(v, o));
    return v;
}
__device__ __forceinline__ float sigmoidf_(float x) { return 1.0f / (1.0f + __expf(-x)); }
__device__ __forceinline__ float gelu_tanh(float x) {
    const float u = 0.7978845608028654f * (x + 0.044715f * x * x * x);
    const float t = 1.0f - 2.0f / (1.0f + __expf(2.0f * u));
    return 0.5f * x * (1.0f + t);
}
__device__ __forceinline__ float siluf_(float x) { return x / (1.0f + __expf(-x)); }

namespace pg8 {
constexpr int BM = 256, BK = 64, HALF = 128, HTB = HALF * BK * 2, STAGE_BYTES = 8 * HTB, NXCD = 8, WGM = 8;
__host__ __device__ __forceinline__ int lds_byte(int r, int c) { const int st = (r >> 4) * 2 + (c >> 5), rr = r & 15, cc = c & 31, ob = rr * 64 + cc * 2; return st * 1024 + (ob ^ (((ob >> 9) & 1) << 5)); }
__host__ __device__ __forceinline__ void stage_rc(int b, int& R, int& C) { const int st = b / 1024, sb = b % 1024, swz = sb ^ (((sb >> 9) & 1) << 5); R = (st >> 1) * 16 + swz / 64; C = (st & 1) * 32 + (swz % 64) / 2; }
__host__ __device__ __forceinline__ int perm32(int rho) { const int n = rho >> 4, i = rho & 15; return 8 * (i >> 2) + 4 * n + (i & 3); }

struct Unit { int pm, pn, sg; };
struct Gemm { const bf16_t* A; const bf16_t* Bt; size_t sgA, sgB; int M, N, K, lda, ldb, nS; };

struct StaticOrder {
    int nM, nN, nS, nwg, G, c;
    __device__ void init(int M_, int N_, int nS_, int G_, int c_) { nM = M_ / BM; nN = N_ / BM; nS = nS_; nwg = nM * nN; G = G_; c = c_; }
    __device__ bool next(int i, Unit& u) const {
        const long L = (long)i * G + c; if (L >= (long)nwg * nS) return false;
        int wgid = (int)(L % nwg); u.sg = (int)(L / nwg);
        { const int q = nwg / NXCD, r = nwg % NXCD, xcd = wgid % NXCD, off = wgid / NXCD; wgid = (xcd < r ? xcd * (q + 1) : r * (q + 1) + (xcd - r) * q) + off; }
        const int nig = WGM * nN, gid = wgid / nig, fm = gid * WGM, gsz = (nM - fm) < WGM ? (nM - fm) : WGM;
        u.pm = fm + ((wgid % nig) % gsz); u.pn = (wgid % nig) / gsz; return true;
    }
};

struct EpiF32 {
    static constexpr bool PERM = false;
    float* C; size_t sgC; int ldc, pad_;
    __device__ __forceinline__ void operator()(const f32x4 (&acc)[2][2][4][2], const Unit& u, int wr, int wc, int fr, int fq) const {
        const int row0 = u.pm * BM + wr * 64 + fr, col0 = u.pn * BM + wc * 32 + 4 * fq;
        float* Cb = C + (size_t)u.sg * sgC;
#pragma unroll
        for (int ai = 0; ai < 2; ++ai)
#pragma unroll
            for (int m = 0; m < 4; ++m) { float* rowp = Cb + (size_t)(row0 + ai * HALF + m * 16) * ldc + col0;
#pragma unroll
                for (int bj = 0; bj < 2; ++bj)
#pragma unroll
                    for (int n = 0; n < 2; ++n) *(f32x4*)(rowp + bj * HALF + n * 16) = acc[ai][bj][m][n]; }
    }
};
struct EpiB16 {
    static constexpr bool PERM = true;
    bf16_t* O; const float* colscale; size_t sgC; int ldc, sgScale;
    __device__ __forceinline__ void operator()(const f32x4 (&acc)[2][2][4][2], const Unit& u, int wr, int wc, int fr, int fq) const {
        const int row0 = u.pm * BM + wr * 64 + fr, col0 = u.pn * BM + wc * 32 + 8 * fq;
        bf16_t* Ob = O + (size_t)u.sg * sgC;
        f32x4 sv[2][2];
#pragma unroll
        for (int bj = 0; bj < 2; ++bj)
#pragma unroll
            for (int n = 0; n < 2; ++n) sv[bj][n] = colscale ? *(const f32x4*)(colscale + u.sg * sgScale + col0 + bj * HALF + 4 * n) : (f32x4){1.f, 1.f, 1.f, 1.f};
#pragma unroll
        for (int ai = 0; ai < 2; ++ai)
#pragma unroll
            for (int m = 0; m < 4; ++m) { bf16_t* rowp = Ob + (size_t)(row0 + ai * HALF + m * 16) * ldc + col0;
#pragma unroll
                for (int bj = 0; bj < 2; ++bj) { const f32x4 v0 = acc[ai][bj][m][0] * sv[bj][0], v1 = acc[ai][bj][m][1] * sv[bj][1];
                    u32x4 w; w.x = cvt_pk_bf16(v0[0], v0[1]); w.y = cvt_pk_bf16(v0[2], v0[3]); w.z = cvt_pk_bf16(v1[0], v1[1]); w.w = cvt_pk_bf16(v1[2], v1[3]);
                    *(u32x4*)(rowp + bj * HALF) = w; } }
    }
};

template <class Epi, class Sched>
__device__ __forceinline__ void gemm_phase(LAS unsigned char* lds, const Gemm g, const Sched& S, const Epi& E) {
    const int tid = threadIdx.x, wid = __builtin_amdgcn_readfirstlane(tid >> 6), lane = tid & 63, wr = wid >> 2, wc = wid & 3, fr = lane & 15, fq = lane >> 4;
    const int K = g.K, nt = K / BK;
    unsigned voffA[2], voffB[2];
#pragma unroll
    for (int i = 0; i < 2; ++i) { int R, C; stage_rc(tid * 16 + i * 8192, R, C); const int Rb = Epi::PERM ? ((R & ~31) + perm32(R & 31)) : R;
        voffA[i] = (unsigned)(R * g.lda + C) * 2u; voffB[i] = (unsigned)(Rb * g.ldb + C) * 2u; }
    const size_t kstep = (size_t)(BK * 2);
    const size_t hstepA = (size_t)HALF * g.lda * 2, hstepB = (size_t)HALF * g.ldb * 2;
    const size_t tstepA = 2 * hstepA, tstepB = 2 * hstepB;
    const unsigned ldsw = (unsigned)wid * 1024u;
    const int aoff = lds_byte(wr * 64 + fr, fq * 8), boff = lds_byte(wc * 32 + fr, fq * 8);
#define PG8_SA(b, h) (((b) * 2 + (h)) * HTB)
#define PG8_SB(b, h) ((4 + (b) * 2 + (h)) * HTB)
#define PG8_STAGE(bufoff, gbase, voff) do { _Pragma("unroll") for (int _i = 0; _i < 2; ++_i) \
        __builtin_amdgcn_global_load_lds((const unsigned*)((const char*)(gbase) + (voff)[_i]), (LAS unsigned*)(lds + (bufoff) + ldsw + _i * 8192), 16, 0, 0); } while (0)
#define PG8_LDA(dst, b, h) do { _Pragma("unroll") for (int m = 0; m < 4; ++m) _Pragma("unroll") for (int k = 0; k < 2; ++k) dst[m][k] = *(const LAS bf16x8*)(lds + PG8_SA(b, h) + aoff + m * 2048 + k * 1024); } while (0)
#define PG8_LDB(dst, b, h) do { _Pragma("unroll") for (int n = 0; n < 2; ++n) _Pragma("unroll") for (int k = 0; k < 2; ++k) dst[n][k] = *(const LAS bf16x8*)(lds + PG8_SB(b, h) + boff + n * 2048 + k * 1024); } while (0)
#define PG8_MMA(ai, bj, At, Bt) do { __builtin_amdgcn_s_setprio(1); _Pragma("unroll") for (int m = 0; m < 4; ++m) _Pragma("unroll") for (int n = 0; n < 2; ++n) _Pragma("unroll") for (int k = 0; k < 2; ++k) \
        acc[ai][bj][m][n] = __builtin_amdgcn_mfma_f32_16x16x32_bf16(Bt[n][k], At[m][k], acc[ai][bj][m][n], 0, 0, 0); __builtin_amdgcn_s_setprio(0); } while (0)
#define PG8_WAIT_V(n) asm volatile("s_waitcnt vmcnt(" #n ")" ::: "memory")
#define PG8_WAIT_L(n) asm volatile("s_waitcnt lgkmcnt(" #n ")" ::: "memory")
#define PG8_BAR __builtin_amdgcn_s_barrier()
#define PG8_SCHED __builtin_amdgcn_sched_barrier(0)
    Unit cur, nxt; int ui = 0;
    if (!S.next(0, cur)) return;
    f32x4 acc[2][2][4][2];
#pragma unroll
    for (int a = 0; a < 2; ++a)
#pragma unroll
        for (int b = 0; b < 2; ++b)
#pragma unroll
            for (int m = 0; m < 4; ++m)
#pragma unroll
                for (int n = 0; n < 2; ++n) acc[a][b][m][n] = (f32x4){0.f, 0.f, 0.f, 0.f};
    bf16x8 At[4][2], B0[2][2], B1[2][2];
    const char* cA = (const char*)(g.A + (size_t)cur.sg * g.sgA) + (size_t)cur.pm * tstepA; const char* cB = (const char*)(g.Bt + (size_t)cur.sg * g.sgB) + (size_t)cur.pn * tstepB;
    PG8_STAGE(PG8_SB(0, 0), cB, voffB); PG8_STAGE(PG8_SB(0, 1), cB + hstepB, voffB); PG8_STAGE(PG8_SA(0, 0), cA, voffA); PG8_STAGE(PG8_SA(0, 1), cA + hstepA, voffA);
    if (wr == 1) PG8_BAR;
    PG8_WAIT_V(2); PG8_BAR;
    PG8_STAGE(PG8_SB(1, 0), cB + kstep, voffB); PG8_STAGE(PG8_SA(1, 0), cA + kstep, voffA); PG8_STAGE(PG8_SB(1, 1), cB + hstepB + kstep, voffB);
    PG8_WAIT_V(6); PG8_BAR;
    for (;;) {
        const bool has_next = S.next(ui + 1, nxt);
        const char* nA = has_next ? (const char*)(g.A + (size_t)nxt.sg * g.sgA) + (size_t)nxt.pm * tstepA : cA;
        const char* nB = has_next ? (const char*)(g.Bt + (size_t)nxt.sg * g.sgB) + (size_t)nxt.pn * tstepB : cB;
        for (int t = 0; t < nt; t += 2) {
            const bool last = (t == nt - 2);
            const char* a1 = cA + (size_t)(t + 1) * kstep;
            const char* a2 = last ? nA : cA + (size_t)(t + 2) * kstep; const char* b2 = last ? nB : cB + (size_t)(t + 2) * kstep;
            const char* a3 = a2 + kstep; const char* b3 = b2 + kstep;
            PG8_LDB(B0, 0, 0); PG8_LDB(B1, 0, 1); PG8_SCHED; PG8_LDA(At, 0, 0); PG8_STAGE(PG8_SA(1, 1), a1 + hstepA, voffA);
            PG8_WAIT_V(8); PG8_WAIT_L(0); PG8_BAR; PG8_MMA(0, 0, At, B0); PG8_MMA(0, 1, At, B1); PG8_BAR; PG8_SCHED;
            PG8_LDA(At, 0, 1); PG8_STAGE(PG8_SB(0, 0), b2, voffB); PG8_STAGE(PG8_SB(0, 1), b2 + hstepB, voffB); PG8_STAGE(PG8_SA(0, 0), a2, voffA);
            PG8_WAIT_V(8); PG8_WAIT_L(0); PG8_BAR; PG8_MMA(1, 0, At, B0); PG8_MMA(1, 1, At, B1); PG8_BAR; PG8_SCHED;
            PG8_LDB(B0, 1, 0); PG8_LDB(B1, 1, 1); PG8_SCHED; PG8_LDA(At, 1, 0); PG8_STAGE(PG8_SA(0, 1), a2 + hstepA, voffA);
            PG8_WAIT_V(8); PG8_WAIT_L(0); PG8_BAR; PG8_MMA(0, 0, At, B0); PG8_MMA(0, 1, At, B1); PG8_BAR; PG8_SCHED;
            PG8_LDA(At, 1, 1); PG8_STAGE(PG8_SB(1, 0), b3, voffB); PG8_STAGE(PG8_SB(1, 1), b3 + hstepB, voffB); PG8_STAGE(PG8_SA(1, 0), a3, voffA);
            PG8_WAIT_V(8); PG8_WAIT_L(0); PG8_BAR; PG8_MMA(1, 0, At, B0); PG8_MMA(1, 1, At, B1); PG8_BAR; PG8_SCHED;
        }
        if (wr == 0) PG8_BAR;
        E(acc, cur, wr, wc, fr, fq);
        if (!has_next) break;
#pragma unroll
        for (int a = 0; a < 2; ++a)
#pragma unroll
            for (int b = 0; b < 2; ++b)
#pragma unroll
                for (int m = 0; m < 4; ++m)
#pragma unroll
                    for (int n = 0; n < 2; ++n) acc[a][b][m][n] = (f32x4){0.f, 0.f, 0.f, 0.f};
        cur = nxt; cA = nA; cB = nB; ++ui;
        if (wr == 1) PG8_BAR;
    }
    PG8_WAIT_V(0);
    PG8_BAR;
#undef PG8_SA
#undef PG8_SB
#undef PG8_STAGE
#undef PG8_LDA
#undef PG8_LDB
#undef PG8_MMA
#undef PG8_WAIT_V
#undef PG8_WAIT_L
#undef PG8_BAR
#undef PG8_SCHED
}
}

constexpr size_t MiB = 1u << 20;
constexpr size_t al(size_t x) { return (x + 4095) & ~(size_t)4095; }
constexpr size_t SZ_W13 = (size_t)2 * F * D * 2, SZ_W2 = (size_t)D * F * 2, SZ_WIN = (size_t)NIN * D * 2, SZ_WBR = (size_t)4 * D * 1024 * 2, SZ_WOUT = (size_t)D * D * 2,
                 SZ_WPG = (size_t)D * D * 2, SZ_WPP = (size_t)D * PLE * 2, SZ_WPOOL = (size_t)4 * 256 * 256 * 2;
constexpr size_t WS_CTL = 0;
constexpr size_t WS_W13A = 1 * MiB;
constexpr size_t WS_W2A = WS_W13A + al(SZ_W13);
constexpr size_t WS_WIN = WS_W2A + al(SZ_W2);
constexpr size_t WS_WBR = WS_WIN + al(SZ_WIN);
constexpr size_t WS_WOUT = WS_WBR + al(SZ_WBR);
constexpr size_t WS_W13B = WS_WOUT + al(SZ_WOUT);
constexpr size_t WS_W2B = WS_W13B + al(SZ_W13);
constexpr size_t WS_WPG = WS_W2B + al(SZ_W2);
constexpr size_t WS_WPP = WS_WPG + al(SZ_WPG);
constexpr size_t WS_WPOOL = WS_WPP + al(SZ_WPP);
constexpr size_t WS_PB = WS_WPOOL + al(SZ_WPOOL);
constexpr size_t WS_XN = WS_PB + al((size_t)NL * M * PLE * 2);
constexpr size_t WS_T32 = WS_XN + al((size_t)M * D * 2);
constexpr size_t WS_T32B = WS_T32 + al((size_t)M * D * 4);
constexpr size_t WS_PROJ = WS_T32B + al((size_t)M * D * 4);
constexpr size_t WS_U = WS_PROJ;
constexpr size_t WS_H = WS_U + al((size_t)M * 2 * F * 2);
constexpr size_t WS_XC = WS_PROJ + al((size_t)M * NIN * 2);
constexpr size_t WS_AF = WS_XC + al((size_t)M * 1024 * 4);
constexpr size_t WS_UF = WS_AF + al((size_t)M * 1024 * 4);
constexpr size_t WS_PL = WS_UF + al((size_t)M * 1024 * 4);
constexpr size_t WS_UG = WS_PL + al((size_t)M * 1024 * 2);
constexpr size_t WS_VVN = WS_UG + al((size_t)M * 1024 * 2);
constexpr size_t WS_Y = WS_VVN + al((size_t)M * 1024 * 2);
constexpr size_t WS_MRGB = WS_Y + al((size_t)4 * M * 1024 * 2);
constexpr size_t WS_END = WS_MRGB + al((size_t)M * D * 2);
static_assert(WS_H + (size_t)M * F * 2 <= WS_XC, "U/H overlay fits inside PROJ");

struct Args { const float* in[32]; float* out; unsigned char* ws; };

struct Ctx { int tid, lane, wave, gw, NGW, gtid, NGT; LAS unsigned char* lds; };

__device__ __forceinline__ void tr_item(const float* W, int ldw, int k0, int n0, bf16_t* WT, int ldt, int drow0, const float* ksc, LAS float* scr, int lane) {
#pragma unroll 8
    for (int i = 0; i < 32; ++i) { const int kk = 2 * i + (lane >> 5); float v = W[(size_t)(k0 + kk) * ldw + n0 + (lane & 31)]; if (ksc) v *= ksc[k0 + kk]; scr[kk * 33 + (lane & 31)] = v; }
    asm volatile("s_waitcnt lgkmcnt(0)" ::: "memory");
    const int c = lane & 7;
#pragma unroll
    for (int j = 0; j < 4; ++j) { const int n = (lane >> 3) + 8 * j; const LAS float* s = scr + (8 * c) * 33 + n;
        u32x4 o; o.x = pk2(s[0 * 33], s[1 * 33]); o.y = pk2(s[2 * 33], s[3 * 33]); o.z = pk2(s[4 * 33], s[5 * 33]); o.w = pk2(s[6 * 33], s[7 * 33]);
        *(u32x4*)(WT + (size_t)(drow0 + n) * ldt + k0 + 8 * c) = o; }
    asm volatile("s_waitcnt lgkmcnt(0)" ::: "memory");
}
__device__ __forceinline__ void tr_matrix(const Ctx& c, const float* W, int K, int N, bf16_t* WT, const float* ksc, int mode  ) {
    LAS float* scr = (LAS float*)(c.lds + c.wave * 16384);
    const int nblk = N / 32, nitems = (K / 64) * nblk;
    for (int it = c.gw; it < nitems; it += c.NGW) {
        const int kb = it / nblk, nb = it % nblk, k0 = 64 * kb, n0 = 32 * nb;
        int drow0 = n0;
        if (mode) drow0 = (n0 / 128) * 256 + (n0 % 128) + (mode == 2 ? 128 : 0);
        tr_item(W, N, k0, n0, WT, K, drow0, ksc, scr, c.lane);
    }
}

__device__ __forceinline__ void phase_prep(const Ctx& c, const Args& a, int l) {
    unsigned char* ws = a.ws;
    tr_matrix(c, a.in[3] + (size_t)l * D * F, D, F, (bf16_t*)(ws + WS_W13A), nullptr, 1);
    tr_matrix(c, a.in[4] + (size_t)l * D * F, D, F, (bf16_t*)(ws + WS_W13A), nullptr, 2);
    tr_matrix(c, a.in[5] + (size_t)l * F * D, F, D, (bf16_t*)(ws + WS_W2A), nullptr, 0);
    tr_matrix(c, a.in[7] + (size_t)l * D * NIN, D, NIN, (bf16_t*)(ws + WS_WIN), nullptr, 0);
    for (int b = 0; b < 4; ++b) tr_matrix(c, a.in[23] + ((size_t)l * 4 + b) * 1024 * D, 1024, D, (bf16_t*)(ws + WS_WBR) + (size_t)b * D * 1024, nullptr, 0);
    tr_matrix(c, a.in[24] + (size_t)l * D * D, D, D, (bf16_t*)(ws + WS_WOUT), nullptr, 0);
    tr_matrix(c, a.in[26] + (size_t)l * D * F, D, F, (bf16_t*)(ws + WS_W13B), nullptr, 1);
    tr_matrix(c, a.in[27] + (size_t)l * D * F, D, F, (bf16_t*)(ws + WS_W13B), nullptr, 2);
    tr_matrix(c, a.in[28] + (size_t)l * F * D, F, D, (bf16_t*)(ws + WS_W2B), nullptr, 0);
    tr_matrix(c, a.in[30] + (size_t)l * D * D, D, D, (bf16_t*)(ws + WS_WPG), nullptr, 0);
    tr_matrix(c, a.in[31] + (size_t)l * PLE * D, PLE, D, (bf16_t*)(ws + WS_WPP), nullptr, 0);
    for (int g = 0; g < 4; ++g) tr_matrix(c, a.in[16] + ((size_t)l * 4 + g) * 256 * 256, 256, 256, (bf16_t*)(ws + WS_WPOOL) + (size_t)g * 256 * 256, nullptr, 0);
    if (l == 0) {
        const float* p = a.in[1]; bf16_t* pb = (bf16_t*)(ws + WS_PB);
        const size_t n4 = (size_t)NL * M * PLE / 4;
        for (size_t i = c.gtid; i < n4; i += c.NGT) { const f32x4 v = *(const f32x4*)(p + 4 * i); u32x2 w; w.x = pk2(v[0], v[1]); w.y = pk2(v[2], v[3]); *(u32x2*)(pb + 4 * i) = w; }
    }
}

__device__ __forceinline__ void phase_row(const Ctx& c, int mode, const float* xin, float* X, const float* T, const float* T2, float alpha, const float* g, bf16_t* XN) {
    for (int m = c.gw; m < M; m += c.NGW) {
        f32x4 v[8]; float ss = 0.f;
#pragma unroll
        for (int j = 0; j < 8; ++j) {
            const size_t o = (size_t)m * D + 256 * j + 4 * c.lane;
            f32x4 x;
            if (mode == 0) x = *(const f32x4*)(xin + o);
            else { x = *(const f32x4*)(X + o); const f32x4 t = *(const f32x4*)(T + o);
                if (mode == 1) x = x + alpha * t;
                else { const f32x4 t2 = *(const f32x4*)(T2 + o);
#pragma unroll
                    for (int e = 0; e < 4; ++e) x[e] += sigmoidf_(t[e]) * t2[e]; } }
            *(f32x4*)(X + o) = x; v[j] = x; ss += (x[0] * x[0] + x[1] * x[1]) + (x[2] * x[2] + x[3] * x[3]);
        }
        if (g) {
            const float rstd = rsqrtf(wave_sum(ss) * (1.0f / D) + EPS);
#pragma unroll
            for (int j = 0; j < 8; ++j) { const int col = 256 * j + 4 * c.lane; const f32x4 gv = *(const f32x4*)(g + col);
                u32x2 w; w.x = pk2(v[j][0] * rstd * gv[0], v[j][1] * rstd * gv[1]); w.y = pk2(v[j][2] * rstd * gv[2], v[j][3] * rstd * gv[3]);
                *(u32x2*)(XN + (size_t)m * D + col) = w; }
        }
    }
}

__device__ __forceinline__ void phase_silu(const Ctx& c, const bf16_t* U, bf16_t* H) {
    const size_t n = (size_t)M * F / 2;
    for (size_t i = c.gtid; i < n; i += c.NGT) {
        const size_t e = 2 * i; const int m = (int)(e / F), h = (int)(e % F);
        const size_t uo = (size_t)m * 2 * F + (h / 128) * 256 + (h % 128);
        const unsigned a = *(const unsigned*)(U + uo), b = *(const unsigned*)(U + uo + 128);
        *(unsigned*)(H + e) = pk2(siluf_(bflo(a)) * bflo(b), siluf_(bfhi(a)) * bfhi(b));
    }
}

__device__ __forceinline__ void phase_mix1(const Ctx& c, const Args& a, int l) {
    unsigned char* ws = a.ws; const bf16_t* P = (const bf16_t*)(ws + WS_PROJ);
    float* XC = (float*)(ws + WS_XC); bf16_t* PL = (bf16_t*)(ws + WS_PL); bf16_t* UG = (bf16_t*)(ws + WS_UG); bf16_t* VVN = (bf16_t*)(ws + WS_VVN);
    const float* cw = a.in[9] + (size_t)l * 4 * 1024; const float* cb = a.in[10] + (size_t)l * 1024; const float* sgn = a.in[20] + (size_t)l * 1024;
    for (size_t i = c.gtid; i < (size_t)M * 1024; i += c.NGT) {
        const int m = (int)(i >> 10), ch = (int)(i & 1023), t = m & (SEQ - 1);
        float y = cb[ch];
#pragma unroll
        for (int j = 0; j < 4; ++j) if (t - j >= 0) y += cw[j * 1024 + ch] * bf2f(P[(size_t)(m - j) * NIN + C_XA + ch]);
        XC[i] = y;
        const int win = 2 << (ch >> 8); float s = 0.f; const int cnt = (t + 1 < win) ? t + 1 : win;
        for (int j = 0; j < cnt; ++j) s += bf2f(P[(size_t)(m - j) * NIN + C_XB + ch]);
        PL[i] = (bf16_t)f2bf(s / (float)cnt - bf2f(P[(size_t)m * NIN + C_XB + ch]));
    }
    for (int m = c.gw; m < M; m += c.NGW) {
        float gv[16]; float ss = 0.f;
#pragma unroll
        for (int j = 0; j < 16; ++j) { const int ch = 64 * j + c.lane;
            UG[(size_t)m * 1024 + ch] = (bf16_t)f2bf(gelu_tanh(bf2f(P[(size_t)m * NIN + C_ZU + ch])));
            gv[j] = gelu_tanh(bf2f(P[(size_t)m * NIN + C_ZV + ch])); ss += gv[j] * gv[j]; }
        const float rstd = rsqrtf(wave_sum(ss) * (1.0f / 1024.0f) + EPS);
#pragma unroll
        for (int j = 0; j < 16; ++j) { const int ch = 64 * j + c.lane; VVN[(size_t)m * 1024 + ch] = (bf16_t)f2bf(gv[j] * rstd * sgn[ch]); }
    }
}

__device__ __forceinline__ void phase_mix2(const Ctx& c, const Args& a, int l) {
    unsigned char* ws = a.ws; const bf16_t* P = (const bf16_t*)(ws + WS_PROJ);
    const float* XC = (const float*)(ws + WS_XC); float* AF = (float*)(ws + WS_AF); float* UF = (float*)(ws + WS_UF);
    const bf16_t* UG = (const bf16_t*)(ws + WS_UG); const bf16_t* VVN = (const bf16_t*)(ws + WS_VVN); bf16_t* Y = (bf16_t*)(ws + WS_Y);
    const float* wa = a.in[11] + (size_t)l * 16 * 64 * 64; const float* ba = a.in[12] + (size_t)l * 1024;
    const float* wx = a.in[13] + (size_t)l * 16 * 64 * 64; const float* bx = a.in[14] + (size_t)l * 1024; const float* lam = a.in[15] + (size_t)l * 1024;
    for (size_t i = c.gtid; i < (size_t)M * 1024; i += c.NGT) {
        const int m = (int)(i >> 10), ch = (int)(i & 1023), h = ch >> 6, j = ch & 63;
        float r = ba[ch], g = bx[ch];
        const float* xr = XC + (size_t)m * 1024 + h * 64; const float* war = wa + (size_t)h * 4096 + j; const float* wxr = wx + (size_t)h * 4096 + j;
#pragma unroll 8
        for (int k = 0; k < 64; ++k) { const float xv = xr[k]; r += xv * war[k * 64]; g += xv * wxr[k * 64]; }
        r = sigmoidf_(r); g = sigmoidf_(g);
        const float lm = lam[ch];
        const float sp = (lm > 0.f ? 0.f : -lm) + log1pf(__expf(-fabsf(lm)));
        const float log_a = -8.0f * r * sp;
        const float av = __expf(log_a);
        const float mult = sqrtf(-expm1f(2.0f * log_a));
        AF[i] = av; UF[i] = mult * (g * XC[i]);
    }
    const float* sgw = a.in[21] + (size_t)l * 8 * 128 * 128; const float* sgb = a.in[22] + (size_t)l * 8 * 128;
    for (size_t i = c.gtid; i < (size_t)M * 1024; i += c.NGT) {
        const int m = (int)(i >> 10), ch = (int)(i & 1023), g = ch >> 7, t = m & 127, base = m - t;
        const float* wr_ = sgw + ((size_t)g * 128 + t) * 128; float acc = sgb[g * 128 + t];
        for (int s = 0; s <= t; ++s) acc += wr_[s] * bf2f(VVN[(size_t)(base + s) * 1024 + ch]);
        Y[(size_t)3 * M * 1024 + i] = (bf16_t)f2bf(bf2f(UG[i]) * acc);
    }
    const float* qg = a.in[18] + (size_t)l * 128; const float* kg = a.in[19] + (size_t)l * 128;
    LAS float* qs = (LAS float*)(c.lds + c.wave * 512);
    const float kgl0 = kg[2 * c.lane], kgl1 = kg[2 * c.lane + 1], qgl0 = qg[2 * c.lane], qgl1 = qg[2 * c.lane + 1];
    for (int w = c.gw; w < M * 8; w += c.NGW) {
        const int m = w >> 3, h = w & 7, t = m & (SEQ - 1), bstart = m - t;
        float mg[3], dg[3], o0[3], o1[3];
#pragma unroll
        for (int g = 0; g < 3; ++g) {
            const int dil = (g == 0) ? 1 : (g == 1 ? 4 : 16);
            const unsigned qw = *(const unsigned*)(P + (size_t)m * NIN + C_Q + (g * 8 + h) * 128 + 2 * c.lane);
            const float q0 = bflo(qw), q1 = bfhi(qw);
            const float rq = rsqrtf(wave_sum(q0 * q0 + q1 * q1) * (1.0f / 128.0f) + EPS) * 0.08838834764831845f;
            asm volatile("s_waitcnt lgkmcnt(0)" ::: "memory");
            qs[2 * c.lane] = q0 * rq * qgl0 * kgl0; qs[2 * c.lane + 1] = q1 * rq * qgl1 * kgl1;
            asm volatile("s_waitcnt lgkmcnt(0)" ::: "memory");
            float sc[3];
#pragma unroll
            for (int ps = 0; ps < 3; ++ps) {
                const int j = ps * 64 + c.lane; const int tk = t - j * dil; const bool valid = (j <= 128) && (tk >= 0);
                float s = -1e30f;
                if (valid) {
                    const bf16_t* kp = P + (size_t)(bstart + tk) * NIN + C_K + h * 128; float dot = 0.f, ksq = 0.f;
#pragma unroll 4
                    for (int cc = 0; cc < 16; ++cc) { const u32x4 kv = *(const u32x4*)(kp + 8 * cc);
#pragma unroll
                        for (int e = 0; e < 4; ++e) { const float k0 = bflo(kv[e]), k1 = bfhi(kv[e]); dot += qs[8 * cc + 2 * e] * k0 + qs[8 * cc + 2 * e + 1] * k1; ksq += k0 * k0 + k1 * k1; } }
                    s = dot * rsqrtf(ksq * (1.0f / 128.0f) + EPS);
                }
                sc[ps] = s;
            }
            const float mx = wave_max(fmaxf(sc[0], fmaxf(sc[1], sc[2])));
            float pr[3]; float dsum = 0.f;
#pragma unroll
            for (int ps = 0; ps < 3; ++ps) { pr[ps] = (sc[ps] > -1e29f) ? __expf(sc[ps] - mx) : 0.f; dsum += pr[ps]; }
            dsum = wave_sum(dsum);
            float a0 = 0.f, a1 = 0.f;
            for (int j = 0; j <= 128; ++j) {
                const float pj = __shfl(j < 64 ? pr[0] : (j < 128 ? pr[1] : pr[2]), j & 63);
                int tk = t - j * dil; if (tk < 0) tk = 0;
                const unsigned vw = *(const unsigned*)(P + (size_t)(bstart + tk) * NIN + C_V + h * 128 + 2 * c.lane);
                a0 += pj * bflo(vw); a1 += pj * bfhi(vw);
            }
            mg[g] = mx; dg[g] = dsum; o0[g] = a0; o1[g] = a1;
        }
        const float mm = fmaxf(mg[0], fmaxf(mg[1], mg[2]));
        const float e0 = __expf(mg[0] - mm), e1 = __expf(mg[1] - mm), e2 = __expf(mg[2] - mm);
        const float den = e0 * dg[0] + e1 * dg[1] + e2 * dg[2];
        const float r0 = (e0 * o0[0] + e1 * o0[1] + e2 * o0[2]) / den, r1 = (e0 * o1[0] + e1 * o1[1] + e2 * o1[2]) / den;
        *(unsigned*)(Y + (size_t)2 * M * 1024 + (size_t)m * 1024 + h * 128 + 2 * c.lane) = pk2(r0, r1);
    }
}

__device__ __forceinline__ void phase_scan_local(const Ctx& c, const Args& a) {
    float* AF = (float*)(a.ws + WS_AF); float* UF = (float*)(a.ws + WS_UF);
    for (int i = c.gtid; i < (M / 64) * 1024; i += c.NGT) {
        const int ck = i >> 10, ch = i & 1023; float h = 0.f, A = 1.f;
        for (int r = 0; r < 64; ++r) { const size_t o = (size_t)(ck * 64 + r) * 1024 + ch; const float av = AF[o], uv = UF[o]; h = av * h + uv; A *= av; AF[o] = A; UF[o] = h; }
    }
}
__device__ __forceinline__ void phase_scan_fix(const Ctx& c, const Args& a) {
    const float* AF = (const float*)(a.ws + WS_AF); const float* UF = (const float*)(a.ws + WS_UF); const bf16_t* P = (const bf16_t*)(a.ws + WS_PROJ); bf16_t* Y = (bf16_t*)(a.ws + WS_Y);
    for (int i = c.gtid; i < (M / 64) * 1024; i += c.NGT) {
        const int ck = i >> 10, ch = i & 1023, cpb = SEQ / 64, c0 = (ck / cpb) * cpb;
        float carry = 0.f;
        for (int k = c0; k < ck; ++k) { const size_t o = (size_t)(k * 64 + 63) * 1024 + ch; carry = AF[o] * carry + UF[o]; }
        for (int r = 0; r < 64; ++r) { const size_t m = (size_t)ck * 64 + r, o = m * 1024 + ch; const float h = UF[o] + AF[o] * carry;
            Y[o] = (bf16_t)f2bf(h * gelu_tanh(bf2f(P[m * NIN + C_GA + ch]))); }
    }
}
__device__ __forceinline__ void phase_brmerge(const Ctx& c, const Args& a, int l, int b) {
    const float* T = (const float*)(a.ws + WS_T32); float* MRG = (float*)(a.ws + WS_T32B); const bf16_t* P = (const bf16_t*)(a.ws + WS_PROJ); bf16_t* MB = (bf16_t*)(a.ws + WS_MRGB);
    const float* bg = a.in[8] + ((size_t)l * 4 + b) * D;
    for (size_t i = c.gtid; i < (size_t)M * D / 2; i += c.NGT) {
        const size_t e = 2 * i; const int m = (int)(e / D), d = (int)(e % D);
        const unsigned gw_ = *(const unsigned*)(P + (size_t)m * NIN + C_GATE + b * D + d);
        const f32x2 t = *(const f32x2*)(T + e); f32x2 acc = (b == 0) ? (f32x2){0.f, 0.f} : *(const f32x2*)(MRG + e);
        acc[0] += sigmoidf_(bflo(gw_) + bg[d]) * t[0]; acc[1] += sigmoidf_(bfhi(gw_) + bg[d + 1]) * t[1];
        *(f32x2*)(MRG + e) = acc;
        if (b == 3) *(unsigned*)(MB + e) = pk2(acc[0], acc[1]);
    }
}

constexpr int LDS_BYTES = 147456;
__device__ __forceinline__ Ctx make_ctx(unsigned char* lds_raw) {
    Ctx c; c.lds = (LAS unsigned char*)lds_raw;
    c.tid = threadIdx.x; c.lane = c.tid & 63; c.wave = __builtin_amdgcn_readfirstlane(c.tid >> 6);
    c.gw = blockIdx.x * NWAVES + c.wave; c.NGW = gridDim.x * NWAVES; c.gtid = blockIdx.x * NTHR + c.tid; c.NGT = gridDim.x * NTHR;
    return c;
}
__global__ void __launch_bounds__(NTHR, 2) k_prep(Args args, int l) {
    extern __shared__ __attribute__((aligned(16))) unsigned char lds_raw[];
    const Ctx c = make_ctx(lds_raw);
    phase_prep(c, args, l);
    if (l == 0) phase_row(c, 0, args.in[0], args.out, nullptr, nullptr, 0.f, args.in[2], (bf16_t*)(args.ws + WS_XN));
}
__global__ void __launch_bounds__(NTHR, 2) k_gemm_b16(pg8::Gemm g, pg8::EpiB16 E) {
    extern __shared__ __attribute__((aligned(16))) unsigned char lds_raw[];
    pg8::StaticOrder S; S.init(g.M, g.N, g.nS, gridDim.x, blockIdx.x);
    pg8::gemm_phase<pg8::EpiB16, pg8::StaticOrder>((LAS unsigned char*)lds_raw, g, S, E);
}
__global__ void __launch_bounds__(NTHR, 2) k_gemm_f32(pg8::Gemm g, pg8::EpiF32 E) {
    extern __shared__ __attribute__((aligned(16))) unsigned char lds_raw[];
    pg8::StaticOrder S; S.init(g.M, g.N, g.nS, gridDim.x, blockIdx.x);
    pg8::gemm_phase<pg8::EpiF32, pg8::StaticOrder>((LAS unsigned char*)lds_raw, g, S, E);
}
__global__ void __launch_bounds__(NTHR, 2) k_row(int mode, float* X, const float* T, const float* T2, float alpha, const float* g, bf16_t* XN) {
    extern __shared__ __attribute__((aligned(16))) unsigned char lds_raw[];
    const Ctx c = make_ctx(lds_raw);
    if (mode == 1) phase_row(c, 1, nullptr, X, T, T2, alpha, g, XN); else phase_row(c, 2, nullptr, X, T, T2, alpha, g, XN);
}
__global__ void __launch_bounds__(NTHR, 2) k_silu(const bf16_t* U, bf16_t* H) {
    extern __shared__ __attribute__((aligned(16))) unsigned char lds_raw[];
    const Ctx c = make_ctx(lds_raw); phase_silu(c, U, H);
}
__global__ void __launch_bounds__(NTHR, 2) k_mix1(Args args, int l) {
    extern __shared__ __attribute__((aligned(16))) unsigned char lds_raw[];
    const Ctx c = make_ctx(lds_raw); phase_mix1(c, args, l);
}
__global__ void __launch_bounds__(NTHR, 2) k_mix2(Args args, int l) {
    extern __shared__ __attribute__((aligned(16))) unsigned char lds_raw[];
    const Ctx c = make_ctx(lds_raw); phase_mix2(c, args, l);
}
__global__ void __launch_bounds__(NTHR, 2) k_scanl(Args args) {
    extern __shared__ __attribute__((aligned(16))) unsigned char lds_raw[];
    const Ctx c = make_ctx(lds_raw); phase_scan_local(c, args);
}
__global__ void __launch_bounds__(NTHR, 2) k_scanf(Args args) {
    extern __shared__ __attribute__((aligned(16))) unsigned char lds_raw[];
    const Ctx c = make_ctx(lds_raw); phase_scan_fix(c, args);
}
__global__ void __launch_bounds__(NTHR, 2) k_brm(Args args, int l, int b) {
    extern __shared__ __attribute__((aligned(16))) unsigned char lds_raw[];
    const Ctx c = make_ctx(lds_raw); phase_brmerge(c, args, l, b);
}

static pg8::Gemm mkg(const bf16_t* A, const bf16_t* Bt, int M_, int N_, int K_, int lda, int ldb, size_t sgA, size_t sgB, int nS) { pg8::Gemm g{}; g.A = A; g.Bt = Bt; g.sgA = sgA; g.sgB = sgB; g.M = M_; g.N = N_; g.K = K_; g.lda = lda; g.ldb = ldb; g.nS = nS; return g; }
static pg8::EpiF32 mkf(float* C, int ldc, size_t sgC) { pg8::EpiF32 e{}; e.C = C; e.sgC = sgC; e.ldc = ldc; e.pad_ = 0; return e; }
static pg8::EpiB16 mkb(bf16_t* O, int ldc, size_t sgC, const float* cs, int sgScale) { pg8::EpiB16 e{}; e.O = O; e.colscale = cs; e.sgC = sgC; e.ldc = ldc; e.sgScale = sgScale; return e; }
extern "C" void kernel_launch(void* const* d_in, const int* in_sizes, int n_in, void* d_out, int out_size, void* d_ws, size_t ws_size, hipStream_t stream) {
    static int grid = 0;
    if (grid == 0) {
        if (n_in != 32 || out_size != M * D || ws_size < WS_END) { fprintf(stderr, "kernel_launch: unexpected shapes: n_in %d out %d ws %zu (need %zu)\n", n_in, out_size, ws_size, (size_t)WS_END); grid = -1; return; }
        int dev = 0, cus = 0;
        if (hipGetDevice(&dev) != hipSuccess || hipDeviceGetAttribute(&cus, hipDeviceAttributeMultiprocessorCount, dev) != hipSuccess) { grid = -1; return; }
        bool ok = true;
        ok &= hipFuncSetAttribute((const void*)k_prep, hipFuncAttributeMaxDynamicSharedMemorySize, LDS_BYTES) == hipSuccess;
        ok &= hipFuncSetAttribute((const void*)k_gemm_b16, hipFuncAttributeMaxDynamicSharedMemorySize, LDS_BYTES) == hipSuccess;
        ok &= hipFuncSetAttribute((const void*)k_gemm_f32, hipFuncAttributeMaxDynamicSharedMemorySize, LDS_BYTES) == hipSuccess;
        ok &= hipFuncSetAttribute((const void*)k_row, hipFuncAttributeMaxDynamicSharedMemorySize, LDS_BYTES) == hipSuccess;
        ok &= hipFuncSetAttribute((const void*)k_silu, hipFuncAttributeMaxDynamicSharedMemorySize, LDS_BYTES) == hipSuccess;
        ok &= hipFuncSetAttribute((const void*)k_mix1, hipFuncAttributeMaxDynamicSharedMemorySize, LDS_BYTES) == hipSuccess;
        ok &= hipFuncSetAttribute((const void*)k_mix2, hipFuncAttributeMaxDynamicSharedMemorySize, LDS_BYTES) == hipSuccess;
        ok &= hipFuncSetAttribute((const void*)k_scanl, hipFuncAttributeMaxDynamicSharedMemorySize, LDS_BYTES) == hipSuccess;
        ok &= hipFuncSetAttribute((const void*)k_scanf, hipFuncAttributeMaxDynamicSharedMemorySize, LDS_BYTES) == hipSuccess;
        ok &= hipFuncSetAttribute((const void*)k_brm, hipFuncAttributeMaxDynamicSharedMemorySize, LDS_BYTES) == hipSuccess;
        if (!ok) { fprintf(stderr, "kernel_launch: hipFuncSetAttribute failed\n"); grid = -1; return; }
        grid = cus;
    }
    if (grid < 0) return;
    Args a{};
    for (int i = 0; i < 32; ++i) a.in[i] = (const float*)d_in[i];
    a.out = (float*)d_out; a.ws = (unsigned char*)d_ws;
    unsigned char* ws = a.ws;
    float* X = a.out; bf16_t* XN = (bf16_t*)(ws + WS_XN); float* T32 = (float*)(ws + WS_T32); float* T32B = (float*)(ws + WS_T32B);
    bf16_t* PROJ = (bf16_t*)(ws + WS_PROJ); bf16_t* U = (bf16_t*)(ws + WS_U); bf16_t* H = (bf16_t*)(ws + WS_H); bf16_t* Y = (bf16_t*)(ws + WS_Y);
    const dim3 G(grid), B(NTHR);
#define LAUNCH(k, ...) hipLaunchKernelGGL(k, G, B, LDS_BYTES, stream, __VA_ARGS__)
    for (int l = 0; l < NL; ++l) {
        LAUNCH(k_prep, a, l);
        for (int f = 0; f < 2; ++f) {
            if (f == 1) {
                LAUNCH(k_gemm_b16, (mkg(XN, (const bf16_t*)(ws + WS_WIN), M, NIN, D, D, D, 0, 0, 1)), (mkb(PROJ, NIN, 0, nullptr, 0)));
                LAUNCH(k_mix1, a, l);
                LAUNCH(k_mix2, a, l);
                LAUNCH(k_gemm_b16, (mkg((const bf16_t*)(ws + WS_PL), (const bf16_t*)(ws + WS_WPOOL), M, 256, 256, 1024, 256, 256, 256 * 256, 4)),
                       (mkb(Y + (size_t)1 * M * 1024, 1024, 256, a.in[17] + (size_t)l * 1024, 256)));
                LAUNCH(k_scanl, a);
                LAUNCH(k_scanf, a);
                for (int b = 0; b < 4; ++b) {
                    LAUNCH(k_gemm_f32, (mkg(Y + (size_t)b * M * 1024, (const bf16_t*)(ws + WS_WBR) + (size_t)b * D * 1024, M, D, 1024, 1024, 1024, 0, 0, 1)), (mkf(T32, D, 0)));
                    LAUNCH(k_brm, a, l, b);
                }
                LAUNCH(k_gemm_f32, (mkg((const bf16_t*)(ws + WS_MRGB), (const bf16_t*)(ws + WS_WOUT), M, D, D, D, D, 0, 0, 1)), (mkf(T32, D, 0)));
                LAUNCH(k_row, 1, X, (const float*)T32, (const float*)nullptr, 1.0f, a.in[25] + (size_t)l * D, XN);
            }
            LAUNCH(k_gemm_b16, (mkg(XN, (const bf16_t*)(ws + (f ? WS_W13B : WS_W13A)), M, 2 * F, D, D, D, 0, 0, 1)), (mkb(U, 2 * F, 0, nullptr, 0)));
            LAUNCH(k_silu, (const bf16_t*)U, H);
            LAUNCH(k_gemm_f32, (mkg(H, (const bf16_t*)(ws + (f ? WS_W2B : WS_W2A)), M, D, F, F, F, 0, 0, 1)), (mkf(T32, D, 0)));
            LAUNCH(k_row, 1, X, (const float*)T32, (const float*)nullptr, 0.5f, (f ? a.in[29] : a.in[6]) + (size_t)l * D, XN);
        }
        LAUNCH(k_gemm_f32, (mkg(XN, (const bf16_t*)(ws + WS_WPG), M, D, D, D, D, 0, 0, 1)), (mkf(T32, D, 0)));
        LAUNCH(k_gemm_f32, (mkg((const bf16_t*)(ws + WS_PB) + (size_t)l * M * PLE, (const bf16_t*)(ws + WS_WPP), M, D, PLE, PLE, PLE, 0, 0, 1)), (mkf(T32B, D, 0)));
        LAUNCH(k_row, 2, X, (const float*)T32, (const float*)T32B, 0.f, (l + 1 < NL) ? a.in[2] + (size_t)(l + 1) * D : (const float*)nullptr, XN);
    }
#undef LAUNCH
}
```

```cpp
#include <hip/hip_runtime.h>
#include <cstdio>
#include <cstdint>

#define LAS __attribute__((address_space(3)))
#define GAS __attribute__((address_space(1)))
typedef unsigned short bf16_t;
typedef short bf16x8 __attribute__((ext_vector_type(8)));
typedef float f32x4 __attribute__((ext_vector_type(4)));
typedef float f32x2 __attribute__((ext_vector_type(2)));
typedef unsigned u32x4 __attribute__((ext_vector_type(4)));
typedef unsigned u32x2 __attribute__((ext_vector_type(2)));

constexpr int M = 16384, SEQ = 8192, D = 2048, F = 5504, NL = 4, PLE = 256, NIN = 18432;
constexpr int C_XA = 0, C_GA = 1024, C_XB = 2048, C_Q = 3072, C_K = 6144, C_V = 7168, C_ZU = 8192, C_ZV = 9216, C_GATE = 10240;
constexpr float EPS = 1e-6f;
constexpr int NWAVES = 8, NTHR = 512;

__device__ __forceinline__ unsigned f2bf(float f) { unsigned u = __builtin_bit_cast(unsigned, f); return (u + 0x7fffu + ((u >> 16) & 1u)) >> 16; }
__device__ __forceinline__ unsigned pk2(float lo, float hi) { return f2bf(lo) | (f2bf(hi) << 16); }
__device__ __forceinline__ float bf2f(unsigned short b) { return __builtin_bit_cast(float, ((unsigned)b) << 16); }
__device__ __forceinline__ float bflo(unsigned w) { return __builtin_bit_cast(float, w << 16); }
__device__ __forceinline__ float bfhi(unsigned w) { return __builtin_bit_cast(float, w & 0xffff0000u); }
__device__ __forceinline__ unsigned lo8_pack(float a, float b, float c, float d) {
    a = __builtin_amdgcn_fmed3f(a * 256.f, -224.f, 224.f); b = __builtin_amdgcn_fmed3f(b * 256.f, -224.f, 224.f); c = __builtin_amdgcn_fmed3f(c * 256.f, -224.f, 224.f); d = __builtin_amdgcn_fmed3f(d * 256.f, -224.f, 224.f);
    unsigned w = 0; w = __builtin_amdgcn_cvt_pk_fp8_f32(a, b, w, false); w = __builtin_amdgcn_cvt_pk_fp8_f32(c, d, w, true); return w;
}
__device__ __forceinline__ unsigned cvt_pk_bf16(float lo, float hi) { unsigned r; asm volatile("v_cvt_pk_bf16_f32 %0, %1, %2" : "=v"(r) : "v"(lo), "v"(hi)); return r; }
__device__ __forceinline__ float wave_sum(float v) {
#pragma unroll
    for (int o = 1; o < 64; o <<= 1) v += __shfl_xor(v, o);
    return v;
}
__device__ __forceinline__ float wave_max(float v) {
#pragma unroll
    for (int o = 1; o < 64; o <<= 1) v = fmaxf(v, __shfl_xor(v, o));
    return v;
}
__device__ __forceinline__ float sigmoidf_(float x) { return 1.0f / (1.0f + __expf(-x)); }
__device__ __forceinline__ float gelu_tanh(float x) {
    const float u = 0.7978845608028654f * (x + 0.044715f * x * x * x);
    const float t = 1.0f - 2.0f / (1.0f + __expf(2.0f * u));
    return 0.5f * x * (1.0f + t);
}
__device__ __forceinline__ float siluf_(float x) { return x / (1.0f + __expf(-x)); }

namespace pg8 {
constexpr int BM = 256, BK = 64, HALF = 128, HTB = HALF * BK * 2, STAGE_BYTES = 8 * HTB, NXCD = 8, WGM = 8;
__host__ __device__ __forceinline__ int lds_byte(int r, int c) { const int st = (r >> 4) * 2 + (c >> 5), rr = r & 15, cc = c & 31, ob = rr * 64 + cc * 2; return st * 1024 + (ob ^ (((ob >> 9) & 1) << 5)); }
__host__ __device__ __forceinline__ void stage_rc(int b, int& R, int& C) { const int st = b / 1024, sb = b % 1024, swz = sb ^ (((sb >> 9) & 1) << 5); R = (st >> 1) * 16 + swz / 64; C = (st & 1) * 32 + (swz % 64) / 2; }
__host__ __device__ __forceinline__ int perm32(int rho) { const int n = rho >> 4, i = rho & 15; return 8 * (i >> 2) + 4 * n + (i & 3); }

struct Unit { int pm, pn, sg; };
struct Gemm { const bf16_t* A; const bf16_t* Bt; size_t sgA, sgB; int M, N, K, lda, ldb, nS, K0, pad_; };

struct StaticOrder {
    int nM, nN, nS, nwg, G, c, alt;
    __device__ void init(int M_, int N_, int nS_, int G_, int c_, int alt_ = 0) { nM = M_ / BM; nN = N_ / BM; nS = nS_; nwg = nM * nN; G = G_; c = c_; alt = alt_; }
    __device__ bool next(int i, Unit& u) const {
        const int L = i * G + c; if (L >= nwg * nS) return false;
        if (nM == 64 && nS == 1) {
            const int xcd = L & 7, off = L >> 3; u.sg = 0;
            if (alt) { u.pm = 8 * xcd + (off & 3) + 4 * (off >> 5); u.pn = (off >> 2) & 7; }
            else { u.pm = 8 * xcd + (off & 7); u.pn = off >> 3; }
            return true;
        }
        int wgid = L % nwg; u.sg = L / nwg;
        { const int q = nwg / NXCD, r = nwg % NXCD, xcd = wgid % NXCD, off = wgid / NXCD; wgid = (xcd < r ? xcd * (q + 1) : r * (q + 1) + (xcd - r) * q) + off; }
        const int nig = WGM * nN, gid = wgid / nig, fm = gid * WGM, gsz = (nM - fm) < WGM ? (nM - fm) : WGM;
        u.pm = fm + ((wgid % nig) % gsz); u.pn = (wgid % nig) / gsz; return true;
    }
};

struct EpiPlain {
    static constexpr bool PERM = true, RSTD = false; const float* ss_in_unused() const { return nullptr; }
    bf16_t* O; int ldc, sgC;
    __device__ __forceinline__ bool keep(const Unit&) const { return false; }
    __device__ __forceinline__ void operator()(const f32x4 (&acc)[2][2][4][2], const Unit& u, int wr, int wc, int fr, int fq, const LAS float*) const {
        bf16_t* Ob = O + (size_t)(u.pm * BM + wr * 64 + fr) * ldc + u.pn * BM + wc * 32 + 8 * fq + u.sg * sgC;
#pragma unroll
        for (int ai = 0; ai < 2; ++ai)
#pragma unroll
            for (int m = 0; m < 4; ++m)
#pragma unroll
                for (int bj = 0; bj < 2; ++bj) { const f32x4 v0 = acc[ai][bj][m][0], v1 = acc[ai][bj][m][1];
                    u32x4 w; w.x = cvt_pk_bf16(v0[0], v0[1]); w.y = cvt_pk_bf16(v0[2], v0[3]); w.z = cvt_pk_bf16(v1[0], v1[1]); w.w = cvt_pk_bf16(v1[2], v1[3]);
                    *(u32x4*)(Ob + (size_t)(ai * HALF + m * 16) * ldc + bj * HALF) = w; }
    }
};

__device__ __forceinline__ float ld_agent(const float* p) { return __hip_atomic_load(p, __ATOMIC_RELAXED, __HIP_MEMORY_SCOPE_AGENT); }
__device__ __forceinline__ float rstd_of(const float* ssp, int row, int fq) {
    const f32x4 a = *(const f32x4*)(ssp + (size_t)row * 32 + 8 * fq), b = *(const f32x4*)(ssp + (size_t)row * 32 + 8 * fq + 4);
    float s = ((a[0] + a[1]) + (a[2] + a[3])) + ((b[0] + b[1]) + (b[2] + b[3]));
    s += __shfl_xor(s, 16); s += __shfl_xor(s, 32);
    return rsqrtf(s * (1.0f / 2048.0f) + 1e-6f);
}
__device__ __forceinline__ float gelu_f(float x) { const float u2 = x * (1.5957691216057308f + 0.07135481627f * x * x); return x - x * __builtin_amdgcn_rcpf(1.0f + __expf(u2)); }
__device__ __forceinline__ float sig_f(float x) { return __builtin_amdgcn_rcpf(1.0f + __expf(-x)); }

constexpr int RSTD_TAB = 135168;
__device__ __forceinline__ void fill_rstd(const float* ssp, int pm, LAS float* tab, int tid) {
    if (tid < 256) {
        const float* p = ssp + ((size_t)pm * 256 + tid) * 32; float s = 0.f;
#pragma unroll
        for (int i = 0; i < 8; ++i) { const f32x4 v = *(const f32x4*)(p + 4 * i); s += (v[0] + v[1]) + (v[2] + v[3]); }
        tab[tid] = rsqrtf(s * (1.0f / 2048.0f) + 1e-6f);
    }
    asm volatile("s_waitcnt lgkmcnt(0)" ::: "memory");
}
struct EpiUp {
    static constexpr bool PERM = true, RSTD = true;
    bf16_t* H; const float* ss_in;
    __device__ __forceinline__ void operator()(f32x4 (&acc)[2][2][4][2], const Unit& u, int wr, int wc, int fr, int fq, const LAS float* rtab) const {
        const int row0 = u.pm * BM + wr * 64 + fr, hcol0 = u.pn * 128 + wc * 32 + 8 * fq;
        float rsv[2][4];
#pragma unroll
        for (int ai = 0; ai < 2; ++ai)
#pragma unroll
            for (int m = 0; m < 4; ++m) rsv[ai][m] = rtab[wr * 64 + fr + ai * HALF + m * 16];
#pragma unroll
        for (int ai = 0; ai < 2; ++ai)
#pragma unroll
            for (int m = 0; m < 4; ++m) { const int row = row0 + ai * HALF + m * 16; const float rs = rsv[ai][m];
                u32x4 w;
#pragma unroll
                for (int n = 0; n < 2; ++n) { const f32x4 a1 = acc[ai][0][m][n] * rs, a3 = acc[ai][1][m][n] * rs; float h[4];
#pragma unroll
                    for (int e = 0; e < 4; ++e) h[e] = a1[e] * sig_f(a1[e]) * a3[e];
                    w[2 * n] = cvt_pk_bf16(h[0], h[1]); w[2 * n + 1] = cvt_pk_bf16(h[2], h[3]); }
                *(u32x4*)(H + (size_t)row * 5504 + hcol0) = w; }
    }
    __device__ __forceinline__ bool keep(const Unit&) const { return false; }
};
struct EpiRes {
    static constexpr bool PERM = true, RSTD = true;
    const bf16_t* XHI_in; bf16_t* XHI_out; unsigned char* XLO; float* OUT32; float* ss_out; const float* ss_in; const bf16_t* PP; float alpha; int mode;
    __device__ __forceinline__ void operator()(f32x4 (&acc)[2][2][4][2], const Unit& u, int wr, int wc, int fr, int fq, const LAS float* rtab) const {
        const int row0 = u.pm * BM + wr * 64 + fr, col0 = u.pn * BM + wc * 32 + 8 * fq;
        if (mode && u.sg == 0) {
#pragma unroll
            for (int ai = 0; ai < 2; ++ai)
#pragma unroll
                for (int m = 0; m < 4; ++m)
#pragma unroll
                    for (int bj = 0; bj < 2; ++bj) { const f32x4 v0 = acc[ai][bj][m][0], v1 = acc[ai][bj][m][1];
                        u32x4 w; w[0] = cvt_pk_bf16(v0[0], v0[1]); w[1] = cvt_pk_bf16(v0[2], v0[3]); w[2] = cvt_pk_bf16(v1[0], v1[1]); w[3] = cvt_pk_bf16(v1[2], v1[3]);
                        *(u32x4*)(const_cast<bf16_t*>(PP) + (size_t)(row0 + ai * HALF + m * 16) * 2048 + col0 + bj * HALF) = w; }
            return;
        }
#pragma unroll
        for (int ai = 0; ai < 2; ++ai) {
            float rsv[4];
#pragma unroll
            for (int m = 0; m < 4; ++m) rsv[m] = mode ? rtab[wr * 64 + fr + ai * HALF + m * 16] : 0.f;
#pragma unroll
            for (int mp = 0; mp < 4; mp += 2) {
                u32x4 xh[2][2]; u32x2 xl[2][2]; u32x4 pq[2][2];
#pragma unroll
                for (int mm = 0; mm < 2; ++mm)
#pragma unroll
                    for (int bj = 0; bj < 2; ++bj) { const size_t o = (size_t)(row0 + ai * HALF + (mp + mm) * 16) * 2048 + col0 + bj * HALF;
                        xh[mm][bj] = *(const u32x4*)(XHI_in + o); xl[mm][bj] = *(const u32x2*)(XLO + o);
                        if (mode) pq[mm][bj] = *(const u32x4*)(PP + o); }
#pragma unroll
                for (int mm = 0; mm < 2; ++mm) { const int m = mp + mm; const int row = row0 + ai * HALF + m * 16; const float rs = rsv[m]; float part = 0.f;
#pragma unroll
                    for (int bj = 0; bj < 2; ++bj) { const size_t o = (size_t)row * 2048 + col0 + bj * HALF;
                        const u32x4 hh = xh[mm][bj]; const u32x2 ll = xl[mm][bj];
                        const f32x2 l01 = __builtin_amdgcn_cvt_pk_f32_fp8(ll.x, false), l23 = __builtin_amdgcn_cvt_pk_f32_fp8(ll.x, true), l45 = __builtin_amdgcn_cvt_pk_f32_fp8(ll.y, false), l67 = __builtin_amdgcn_cvt_pk_f32_fp8(ll.y, true);
                        constexpr float LS = 1.0f / 256.0f;
                        f32x4 x0 = (f32x4){bflo(hh[0]) + LS * l01[0], bfhi(hh[0]) + LS * l01[1], bflo(hh[1]) + LS * l23[0], bfhi(hh[1]) + LS * l23[1]};
                        f32x4 x1 = (f32x4){bflo(hh[2]) + LS * l45[0], bfhi(hh[2]) + LS * l45[1], bflo(hh[3]) + LS * l67[0], bfhi(hh[3]) + LS * l67[1]};
                        const f32x4 v0 = acc[ai][bj][m][0], v1 = acc[ai][bj][m][1];
                        if (mode) { const u32x4 pp = pq[mm][bj];
                            x0[0] += sig_f(rs * v0[0]) * bflo(pp[0]); x0[1] += sig_f(rs * v0[1]) * bfhi(pp[0]); x0[2] += sig_f(rs * v0[2]) * bflo(pp[1]); x0[3] += sig_f(rs * v0[3]) * bfhi(pp[1]);
                            x1[0] += sig_f(rs * v1[0]) * bflo(pp[2]); x1[1] += sig_f(rs * v1[1]) * bfhi(pp[2]); x1[2] += sig_f(rs * v1[2]) * bflo(pp[3]); x1[3] += sig_f(rs * v1[3]) * bfhi(pp[3]); }
                        else { x0 = x0 + alpha * v0; x1 = x1 + alpha * v1; }
                        u32x4 w; w[0] = cvt_pk_bf16(x0[0], x0[1]); w[1] = cvt_pk_bf16(x0[2], x0[3]); w[2] = cvt_pk_bf16(x1[0], x1[1]); w[3] = cvt_pk_bf16(x1[2], x1[3]);
                        *(u32x4*)(XHI_out + o) = w;
                        u32x2 wl; wl.x = lo8_pack(x0[0] - bflo(w[0]), x0[1] - bfhi(w[0]), x0[2] - bflo(w[1]), x0[3] - bfhi(w[1]));
                        wl.y = lo8_pack(x1[0] - bflo(w[2]), x1[1] - bfhi(w[2]), x1[2] - bflo(w[3]), x1[3] - bfhi(w[3]));
                        *(u32x2*)(XLO + o) = wl;
                        if (OUT32) { *(f32x4*)(OUT32 + o) = x0; *(f32x4*)(OUT32 + o + 4) = x1; }
                        part += (x0[0] * x0[0] + x0[1] * x0[1]) + (x0[2] * x0[2] + x0[3] * x0[3]) + (x1[0] * x1[0] + x1[1] * x1[1]) + (x1[2] * x1[2] + x1[3] * x1[3]); }
                    part += __shfl_xor(part, 16); part += __shfl_xor(part, 32);
                    if (ss_out && fq == 0) ss_out[(size_t)row * 32 + u.pn * 4 + wc] = part; }
                asm volatile("" ::: "memory");
            }
        }
    }
    __device__ __forceinline__ bool keep(const Unit&) const { return false; }
};
struct EpiIn {
    static constexpr bool PERM = true, RSTD = true;
    bf16_t* O; const float* ss_in; float* ssv; const float* bgate;
    __device__ __forceinline__ void operator()(f32x4 (&acc)[2][2][4][2], const Unit& u, int wr, int wc, int fr, int fq, const LAS float* rtab) const {
        const int row0 = u.pm * BM + wr * 64 + fr, col0 = u.pn * BM + wc * 32 + 8 * fq;
        const bool is_zv = (u.pn >= 36 && u.pn < 40);
        const bool do_gelu = (u.pn >= 4 && u.pn < 8) || (u.pn >= 32 && u.pn < 40);
        float rsv[2][4];
#pragma unroll
        for (int ai = 0; ai < 2; ++ai)
#pragma unroll
            for (int m = 0; m < 4; ++m) rsv[ai][m] = rtab[wr * 64 + fr + ai * HALF + m * 16];
        if (u.pn >= 40) {
            const int dbase = 64 * (u.pn - 40) + 16 * wc + 4 * fq;
            f32x4 bg[4];
#pragma unroll
            for (int b = 0; b < 4; ++b) bg[b] = *(const f32x4*)(bgate + b * 2048 + dbase);
#pragma unroll
            for (int ai = 0; ai < 2; ++ai)
#pragma unroll
                for (int m = 0; m < 4; ++m) { const int row = row0 + ai * HALF + m * 16; const float rs = rsv[ai][m];
                    f32x4 t[4], iv[4];
#pragma unroll
                    for (int b = 0; b < 4; ++b) { const f32x4 v = acc[ai][b >> 1][m][b & 1] * rs + bg[b];
#pragma unroll
                        for (int e = 0; e < 4; ++e) { const float x = fminf(fmaxf(v[e], -30.f), 30.f); t[b][e] = 1.0f + __expf(-x); iv[b][e] = __builtin_amdgcn_rcpf(t[b][e]); } }
                    bf16_t* op = O + (size_t)row * 18432 + 10240 + dbase;
#pragma unroll
                    for (int b = 0; b < 4; ++b) { const f32x4 r = (b < 3) ? t[b + 1] * iv[b] : iv[3];
                        u32x2 w; w.x = cvt_pk_bf16(r[0], r[1]); w.y = cvt_pk_bf16(r[2], r[3]); *(u32x2*)(op + b * 2048) = w; } }
            return;
        }
#pragma unroll
        for (int ai = 0; ai < 2; ++ai)
#pragma unroll
            for (int m = 0; m < 4; ++m) { const int row = row0 + ai * HALF + m * 16; const float rs = rsv[ai][m]; float part = 0.f;
#pragma unroll
                for (int bj = 0; bj < 2; ++bj) { f32x4 v0 = acc[ai][bj][m][0] * rs, v1 = acc[ai][bj][m][1] * rs;
                    if (do_gelu) {
#pragma unroll
                        for (int e = 0; e < 4; ++e) { v0[e] = gelu_f(v0[e]); v1[e] = gelu_f(v1[e]); } }
                    u32x4 w; w[0] = cvt_pk_bf16(v0[0], v0[1]); w[1] = cvt_pk_bf16(v0[2], v0[3]); w[2] = cvt_pk_bf16(v1[0], v1[1]); w[3] = cvt_pk_bf16(v1[2], v1[3]);
                    *(u32x4*)(O + (size_t)row * 18432 + col0 + bj * HALF) = w;
                    if (is_zv) part += (v0[0] * v0[0] + v0[1] * v0[1]) + (v0[2] * v0[2] + v0[3] * v0[3]) + (v1[0] * v1[0] + v1[1] * v1[1]) + (v1[2] * v1[2] + v1[3] * v1[3]); }
                if (is_zv) { part += __shfl_xor(part, 16); part += __shfl_xor(part, 32); if (fq == 0) ssv[(size_t)row * 16 + (u.pn - 36) * 4 + wc] = part; } }
    }
    __device__ __forceinline__ bool keep(const Unit&) const { return false; }
};

struct EpiBr {
    static constexpr bool PERM = true, RSTD = false;
    const bf16_t* R; bf16_t* O;
    __device__ __forceinline__ bool keep(const Unit& u) const { return u.sg != 3; }
    __device__ __forceinline__ void operator()(f32x4 (&acc)[2][2][4][2], const Unit& u, int wr, int wc, int fr, int fq, const LAS float* rtab) const {
        const int row0 = u.pm * BM + wr * 64 + fr, col0 = u.pn * BM + wc * 32 + 8 * fq;
#pragma unroll
        for (int ai = 0; ai < 2; ++ai) {
            u32x4 rr[4][2];
#pragma unroll
            for (int m = 0; m < 4; ++m)
#pragma unroll
                for (int bj = 0; bj < 2; ++bj) rr[m][bj] = *(const u32x4*)(R + (size_t)(row0 + ai * HALF + m * 16) * 18432 + u.sg * 2048 + col0 + bj * HALF);
#pragma unroll
            for (int m = 0; m < 4; ++m) { const int row = row0 + ai * HALF + m * 16;
#pragma unroll
                for (int bj = 0; bj < 2; ++bj) { const int col = col0 + bj * HALF;
                    const u32x4 r = rr[m][bj];
                    f32x4 v0 = acc[ai][bj][m][0], v1 = acc[ai][bj][m][1];
                    v0[0] *= bflo(r[0]); v0[1] *= bfhi(r[0]); v0[2] *= bflo(r[1]); v0[3] *= bfhi(r[1]);
                    v1[0] *= bflo(r[2]); v1[1] *= bfhi(r[2]); v1[2] *= bflo(r[3]); v1[3] *= bfhi(r[3]);
                    acc[ai][bj][m][0] = v0; acc[ai][bj][m][1] = v1;
                    if (u.sg == 3) { u32x4 w; w[0] = cvt_pk_bf16(v0[0], v0[1]); w[1] = cvt_pk_bf16(v0[2], v0[3]); w[2] = cvt_pk_bf16(v1[0], v1[1]); w[3] = cvt_pk_bf16(v1[2], v1[3]);
                        *(u32x4*)(O + (size_t)row * 2048 + col) = w; } } } }
    }
};
struct PleOrder {
    StaticOrder so;
    __device__ bool next(int i, Unit& u) const { Unit t; if (!so.next(i >> 1, t)) return false; u.pm = t.pm; u.pn = t.pn; u.sg = i & 1; return true; }
};
struct BrOrder {
    StaticOrder so;
    __device__ bool next(int i, Unit& u) const { Unit t; if (!so.next(i >> 2, t)) return false; u.pm = t.pm; u.pn = t.pn; u.sg = i & 3; return true; }
};

__device__ __forceinline__ const char* uni_ptr(const char* p) {
    const unsigned long long v = (unsigned long long)p; unsigned lo = __builtin_amdgcn_readfirstlane((unsigned)v), hi = __builtin_amdgcn_readfirstlane((unsigned)(v >> 32));
    asm volatile("" : "+s"(lo), "+s"(hi));
    return (const char*)(((unsigned long long)hi << 32) | lo);
}
__device__ __forceinline__ void glds16_s(const char* sbase, unsigned voff, unsigned lds_dst) {
    unsigned keep;
    asm volatile("s_mov_b32 %0, m0\n\ts_mov_b32 m0, %3\n\ts_nop 0\n\tglobal_load_lds_dwordx4 %1, %2\n\ts_mov_b32 m0, %0" : "=&s"(keep) : "v"(voff), "s"(sbase), "s"(lds_dst) : "memory");
}
template <class Epi, class Sched>
__device__ __forceinline__ void gemm_phase(LAS unsigned char* lds, const Gemm g, const Sched& S, const Epi& E) {
    int tid_ = threadIdx.x; asm volatile("" : "+v"(tid_));
    const int tid = tid_, wid = __builtin_amdgcn_readfirstlane(tid >> 6), lane = tid & 63, wr = wid >> 2, wc = wid & 3, fr = lane & 15, fq = lane >> 4;
    unsigned voffA[2], voffB[2];
#pragma unroll
    for (int i = 0; i < 2; ++i) { int R, C; stage_rc(tid * 16 + i * 8192, R, C); const int Rb = Epi::PERM ? ((R & ~31) + perm32(R & 31)) : R;
        voffA[i] = (unsigned)(R * g.lda + C) * 2u; voffB[i] = (unsigned)(Rb * g.ldb + C) * 2u; }
    constexpr unsigned kstep = BK * 2;
    const unsigned hstepA = (unsigned)HALF * g.lda * 2u, hstepB = (unsigned)HALF * g.ldb * 2u;
    const unsigned tstepA = 2u * hstepA, tstepB = 2u * hstepB;
    const unsigned ldsw = (unsigned)wid * 1024u;
    const unsigned ldsbase = (unsigned)(size_t)lds + ldsw;
    const int aoff = lds_byte(wr * 64 + fr, fq * 8), boff = lds_byte(wc * 32 + fr, fq * 8);
#define PG8_SA(b, h) (((b) * 2 + (h)) * HTB)
#define PG8_SB(b, h) ((4 + (b) * 2 + (h)) * HTB)
#define PG8_STAGE(bufoff, gbase, voff) do { const char* _gb = uni_ptr((const char*)(gbase)); _Pragma("unroll") for (int _i = 0; _i < 2; ++_i) \
        glds16_s(_gb, (voff)[_i], ldsbase + (unsigned)((bufoff) + _i * 8192)); } while (0)
#define PG8_LDA(dst, b, h) do { _Pragma("unroll") for (int m = 0; m < 4; ++m) _Pragma("unroll") for (int k = 0; k < 2; ++k) dst[m][k] = *(const LAS bf16x8*)(lds + PG8_SA(b, h) + aoff + m * 2048 + k * 1024); } while (0)
#define PG8_LDB(dst, b, h) do { _Pragma("unroll") for (int n = 0; n < 2; ++n) _Pragma("unroll") for (int k = 0; k < 2; ++k) dst[n][k] = *(const LAS bf16x8*)(lds + PG8_SB(b, h) + boff + n * 2048 + k * 1024); } while (0)
#define PG8_MMA(ai, bj, At, Bt) do { __builtin_amdgcn_s_setprio(1); _Pragma("unroll") for (int m = 0; m < 4; ++m) _Pragma("unroll") for (int n = 0; n < 2; ++n) _Pragma("unroll") for (int k = 0; k < 2; ++k) \
        acc[ai][bj][m][n] = __builtin_amdgcn_mfma_f32_16x16x32_bf16(Bt[n][k], At[m][k], acc[ai][bj][m][n], 0, 0, 0); __builtin_amdgcn_s_setprio(0); } while (0)
#define PG8_WAIT_V(n) asm volatile("s_waitcnt vmcnt(" #n ")" ::: "memory")
#define PG8_WAIT_L(n) asm volatile("s_waitcnt lgkmcnt(" #n ")" ::: "memory")
#define PG8_BAR __builtin_amdgcn_s_barrier()
#define PG8_SCHED __builtin_amdgcn_sched_barrier(0)
    Unit cur, nxt; int ui = 0;
    if (!S.next(0, cur)) return;
    LAS float* const rtab = (LAS float*)(lds + RSTD_TAB);
    int tab_pm = -1;
    if constexpr (Epi::RSTD) { if (E.ss_in) { fill_rstd(E.ss_in, cur.pm, rtab, tid); tab_pm = cur.pm; } }
    f32x4 acc[2][2][4][2];
#pragma unroll
    for (int a = 0; a < 2; ++a)
#pragma unroll
        for (int b = 0; b < 2; ++b)
#pragma unroll
            for (int m = 0; m < 4; ++m)
#pragma unroll
                for (int n = 0; n < 2; ++n) acc[a][b][m][n] = (f32x4){0.f, 0.f, 0.f, 0.f};
    bf16x8 At[4][2], B0[2][2], B1[2][2];
    const char* cA = (const char*)(g.A + (size_t)cur.sg * g.sgA) + (size_t)((unsigned)cur.pm * tstepA); const char* cB = (const char*)(g.Bt + (size_t)cur.sg * g.sgB) + (size_t)((unsigned)cur.pn * tstepB);
    PG8_STAGE(PG8_SB(0, 0), cB, voffB); PG8_STAGE(PG8_SB(0, 1), cB + hstepB, voffB); PG8_STAGE(PG8_SA(0, 0), cA, voffA); PG8_STAGE(PG8_SA(0, 1), cA + hstepA, voffA);
    if (wr == 1) PG8_BAR;
    PG8_WAIT_V(2); PG8_BAR;
    PG8_STAGE(PG8_SB(1, 0), cB + kstep, voffB); PG8_STAGE(PG8_SA(1, 0), cA + kstep, voffA); PG8_STAGE(PG8_SB(1, 1), cB + hstepB + kstep, voffB);
    PG8_WAIT_V(6); PG8_BAR;
    for (;;) {
        const int nt = ((g.K0 != 0 && cur.sg == 0) ? g.K0 : g.K) / BK;
        const bool has_next = S.next(ui + 1, nxt);
        const char* nA = has_next ? (const char*)(g.A + (size_t)nxt.sg * g.sgA) + (size_t)((unsigned)nxt.pm * tstepA) : cA;
        const char* nB = has_next ? (const char*)(g.Bt + (size_t)nxt.sg * g.sgB) + (size_t)((unsigned)nxt.pn * tstepB) : cB;
        for (int t = 0; t < nt; t += 2) {
            const bool last = (t == nt - 2);
            const char* a1 = cA + (unsigned)(t + 1) * kstep;
            const char* a2 = last ? nA : cA + (unsigned)(t + 2) * kstep; const char* b2 = last ? nB : cB + (unsigned)(t + 2) * kstep;
            const char* a3 = a2 + kstep; const char* b3 = b2 + kstep;
            PG8_LDB(B0, 0, 0); PG8_LDB(B1, 0, 1); PG8_SCHED; PG8_LDA(At, 0, 0); PG8_STAGE(PG8_SA(1, 1), a1 + hstepA, voffA);
            PG8_WAIT_V(8); PG8_WAIT_L(0); PG8_BAR; PG8_MMA(0, 0, At, B0); PG8_MMA(0, 1, At, B1); PG8_BAR; PG8_SCHED;
            PG8_LDA(At, 0, 1); PG8_STAGE(PG8_SB(0, 0), b2, voffB); PG8_STAGE(PG8_SB(0, 1), b2 + hstepB, voffB); PG8_STAGE(PG8_SA(0, 0), a2, voffA);
            PG8_WAIT_V(8); PG8_WAIT_L(0); PG8_BAR; PG8_MMA(1, 0, At, B0); PG8_MMA(1, 1, At, B1); PG8_BAR; PG8_SCHED;
            PG8_LDB(B0, 1, 0); PG8_LDB(B1, 1, 1); PG8_SCHED; PG8_LDA(At, 1, 0); PG8_STAGE(PG8_SA(0, 1), a2 + hstepA, voffA);
            PG8_WAIT_V(8); PG8_WAIT_L(0); PG8_BAR; PG8_MMA(0, 0, At, B0); PG8_MMA(0, 1, At, B1); PG8_BAR; PG8_SCHED;
            PG8_LDA(At, 1, 1); PG8_STAGE(PG8_SB(1, 0), b3, voffB); PG8_STAGE(PG8_SB(1, 1), b3 + hstepB, voffB); PG8_STAGE(PG8_SA(1, 0), a3, voffA);
            PG8_WAIT_V(8); PG8_WAIT_L(0); PG8_BAR; PG8_MMA(1, 0, At, B0); PG8_MMA(1, 1, At, B1); PG8_BAR; PG8_SCHED;
        }
        if (wr == 0) PG8_BAR;
        if constexpr (Epi::RSTD) { if (E.ss_in && cur.pm != tab_pm) { fill_rstd(E.ss_in, cur.pm, rtab, tid); PG8_BAR; tab_pm = cur.pm; } }
        E(acc, cur, wr, wc, fr, fq, rtab);
        if (!has_next) break;
        if (!E.keep(cur)) {
#pragma unroll
        for (int a = 0; a < 2; ++a)
#pragma unroll
            for (int b = 0; b < 2; ++b)
#pragma unroll
                for (int m = 0; m < 4; ++m)
#pragma unroll
                    for (int n = 0; n < 2; ++n) acc[a][b][m][n] = (f32x4){0.f, 0.f, 0.f, 0.f};
        }
        cur = nxt; cA = nA; cB = nB; ++ui;
        if (wr == 1) PG8_BAR;
    }
    PG8_WAIT_V(0);
    PG8_BAR;
#undef PG8_SA
#undef PG8_SB
#undef PG8_STAGE
#undef PG8_LDA
#undef PG8_LDB
#undef PG8_MMA
#undef PG8_WAIT_V
#undef PG8_WAIT_L
#undef PG8_BAR
#undef PG8_SCHED
}
}

constexpr size_t MiB = 1u << 20;
constexpr size_t al(size_t x) { return (x + 4095) & ~(size_t)4095; }
constexpr size_t SZ_W13 = (size_t)2 * F * D * 2, SZ_W2 = (size_t)D * F * 2, SZ_WIN = (size_t)NIN * D * 2, SZ_WBR = (size_t)4 * D * 1024 * 2, SZ_WOUT = (size_t)D * D * 2,
                 SZ_WPG = (size_t)D * D * 2, SZ_WPP = (size_t)D * 2048 * 2  , SZ_WPOOL = (size_t)4 * 256 * 256 * 2;
constexpr size_t WS_CTL = 0;
constexpr size_t WS_W13A = 1 * MiB;
constexpr size_t WS_W2A = WS_W13A + al(SZ_W13);
constexpr size_t WS_WIN = WS_W2A + al(SZ_W2);
constexpr size_t WS_WBR = WS_WIN + al(SZ_WIN);
constexpr size_t WS_WOUT = WS_WBR + al(SZ_WBR);
constexpr size_t WS_W13B = WS_WOUT + al(SZ_WOUT);
constexpr size_t WS_W2B = WS_W13B + al(SZ_W13);
constexpr size_t WS_WPG = WS_W2B + al(SZ_W2);
constexpr size_t WS_WPP = WS_WPG + al(SZ_WPG);
constexpr size_t WS_WPOOL = WS_WPP + al(SZ_WPP);
constexpr size_t WS_WGT = WS_WPOOL + al(SZ_WPOOL);
constexpr size_t WS_WSB = WS_WGT + al((size_t)2 * 16 * 64 * 64 * 2);
constexpr size_t WS_PB = WS_WSB + al((size_t)8 * 128 * 128 * 2);
constexpr size_t WS_XN = WS_PB + al((size_t)M * 2048 * 2);
constexpr size_t WS_XN2 = WS_XN + al((size_t)M * D * 2);
constexpr size_t WS_XLO = WS_XN2 + al((size_t)M * D * 2);
constexpr size_t WS_PROJ = WS_XLO + al((size_t)M * D * 2);
constexpr size_t WS_H = WS_PROJ;
constexpr size_t WS_PL = WS_PROJ + al((size_t)M * NIN * 2);
constexpr size_t WS_Y = WS_PL + al((size_t)M * 1024 * 2);
constexpr size_t WS_MRGB = WS_Y + al((size_t)4 * M * 1024 * 2);
constexpr size_t WS_OG = WS_MRGB + al((size_t)M * D * 2);
constexpr size_t WS_LSE = WS_OG + al((size_t)3 * M * 1024 * 2);
constexpr size_t WS_SS = WS_LSE + al((size_t)3 * M * 8 * 4);
constexpr size_t WS_PP = WS_SS + al((size_t)(NL * 4 + 1) * M * 32 * 4);
constexpr size_t WS_HL = WS_PP + al((size_t)M * D * 2);
constexpr size_t WS_AC = WS_HL + al((size_t)M * 1024 * 2);
constexpr size_t WS_CSA = WS_AC + al((size_t)M * 1024 * 2);
constexpr size_t WS_CSH = WS_CSA + al((size_t)128 * 1024 * 4);
constexpr size_t WS_SSV = WS_CSH + al((size_t)128 * 1024 * 4);
constexpr size_t WS_CIN = WS_SSV + al((size_t)M * 16 * 4);
constexpr size_t WS_END = WS_CIN + al((size_t)128 * 1024 * 4);
static_assert((size_t)M * F * 2 <= (size_t)M * NIN * 2, "H overlay fits inside PROJ");

struct Args { const float* in[32]; float* out; unsigned char* ws; int s_lo, s_hi; };
typedef const Args __attribute__((address_space(4)))* ArgsP;

struct Ctx { int tid, lane, wave, gw, NGW, gtid, NGT, bid, gdim; LAS unsigned char* lds; };

__device__ __forceinline__ void tr_item(const float* W, int ldw, int k0, int n0, bf16_t* WT, int ldt, int drow0, const float* ksc, const float* nsc, LAS float* scr, int lane) {
    {
        const int c4 = (lane & 7) * 4; f32x4 v[8];
#pragma unroll
        for (int i = 0; i < 8; ++i) v[i] = *(const f32x4*)(W + (size_t)(k0 + 8 * i + (lane >> 3)) * ldw + n0 + c4);
        f32x4 ns = (f32x4){1.f, 1.f, 1.f, 1.f}; if (nsc) ns = *(const f32x4*)(nsc + n0 + c4);
#pragma unroll
        for (int i = 0; i < 8; ++i) { const int kk = 8 * i + (lane >> 3); f32x4 x = v[i] * ns; if (ksc) x = x * ksc[k0 + kk];
            scr[kk * 33 + c4] = x[0]; scr[kk * 33 + c4 + 1] = x[1]; scr[kk * 33 + c4 + 2] = x[2]; scr[kk * 33 + c4 + 3] = x[3]; }
    }
    asm volatile("s_waitcnt lgkmcnt(0)" ::: "memory");
    const int c = lane & 7;
#pragma unroll
    for (int j = 0; j < 4; ++j) { const int n = (lane >> 3) + 8 * j; const LAS float* s = scr + (8 * c) * 33 + n;
        u32x4 o; o.x = pk2(s[0 * 33], s[1 * 33]); o.y = pk2(s[2 * 33], s[3 * 33]); o.z = pk2(s[4 * 33], s[5 * 33]); o.w = pk2(s[6 * 33], s[7 * 33]);
        int dr = drow0 + n;
        if (drow0 < 0) {
            const int gcol = n0 + n - C_GATE, b = gcol >> 11, d = gcol & 2047, dl = d & 63;
            dr = C_GATE + 256 * (d >> 6) + 128 * (b >> 1) + 32 * (dl >> 4) + 8 * ((dl >> 2) & 3) + 4 * (b & 1) + (dl & 3);
        }
        *(u32x4*)(WT + (size_t)dr * ldt + k0 + 8 * c) = o; }
    asm volatile("s_waitcnt lgkmcnt(0)" ::: "memory");
}
__device__ __forceinline__ void tr_matrix(const Ctx& c, int& base, const float* W, int K, int N, bf16_t* WT, const float* ksc, int mode  , const float* nsc = nullptr, int ldt = 0) {
    LAS float* scr = (LAS float*)(c.lds + c.wave * 16384);
    const int nblk = N / 32, nitems = (K / 64) * nblk;
    int first = (c.gw - base) % c.NGW; if (first < 0) first += c.NGW;
    base = (base + nitems) % c.NGW;
    for (int it = first; it < nitems; it += c.NGW) {
        const int kb = it / nblk, nb = it % nblk, k0 = 64 * kb, n0 = 32 * nb;
        int drow0 = n0;
        if (mode == 1 || mode == 2) drow0 = (n0 / 128) * 256 + (n0 % 128) + (mode == 2 ? 128 : 0);
        if (mode == 3 && n0 >= C_GATE) drow0 = -1;
        tr_item(W, N, k0, n0, WT, ldt ? ldt : K, drow0, ksc, nsc, scr, c.lane);
    }
}

__device__ __forceinline__ void phase_prep(const Ctx& c, ArgsP a, int l) {
    unsigned char* ws = a->ws; int base = 0;
    tr_matrix(c, base, a->in[3] + (size_t)l * D * F, D, F, (bf16_t*)(ws + WS_W13A), a->in[2] + (size_t)l * D, 1);
    tr_matrix(c, base, a->in[4] + (size_t)l * D * F, D, F, (bf16_t*)(ws + WS_W13A), a->in[2] + (size_t)l * D, 2);
    tr_matrix(c, base, a->in[5] + (size_t)l * F * D, F, D, (bf16_t*)(ws + WS_W2A), nullptr, 0);
    tr_matrix(c, base, a->in[7] + (size_t)l * D * NIN, D, NIN, (bf16_t*)(ws + WS_WIN), a->in[6] + (size_t)l * D, 3);
    for (int b = 0; b < 4; ++b) tr_matrix(c, base, a->in[23] + ((size_t)l * 4 + b) * 1024 * D, 1024, D, (bf16_t*)(ws + WS_WBR) + (size_t)b * D * 1024, nullptr, 0);
    tr_matrix(c, base, a->in[24] + (size_t)l * D * D, D, D, (bf16_t*)(ws + WS_WOUT), nullptr, 0);
    tr_matrix(c, base, a->in[26] + (size_t)l * D * F, D, F, (bf16_t*)(ws + WS_W13B), a->in[25] + (size_t)l * D, 1);
    tr_matrix(c, base, a->in[27] + (size_t)l * D * F, D, F, (bf16_t*)(ws + WS_W13B), a->in[25] + (size_t)l * D, 2);
    tr_matrix(c, base, a->in[28] + (size_t)l * F * D, F, D, (bf16_t*)(ws + WS_W2B), nullptr, 0);
    tr_matrix(c, base, a->in[30] + (size_t)l * D * D, D, D, (bf16_t*)(ws + WS_WPG), a->in[29] + (size_t)l * D, 0);
    tr_matrix(c, base, a->in[31] + (size_t)l * PLE * D, PLE, D, (bf16_t*)(ws + WS_WPP), nullptr, 0, nullptr, 2048);
    for (int g = 0; g < 4; ++g) tr_matrix(c, base, a->in[16] + ((size_t)l * 4 + g) * 256 * 256, 256, 256, (bf16_t*)(ws + WS_WPOOL) + (size_t)g * 256 * 256, nullptr, 0, a->in[17] + (size_t)l * 1024 + g * 256);
    for (int hh = 0; hh < 16; ++hh) {
        tr_matrix(c, base, a->in[11] + ((size_t)l * 16 + hh) * 4096, 64, 64, (bf16_t*)(ws + WS_WGT) + (size_t)hh * 4096, nullptr, 0);
        tr_matrix(c, base, a->in[13] + ((size_t)l * 16 + hh) * 4096, 64, 64, (bf16_t*)(ws + WS_WGT) + (size_t)(16 + hh) * 4096, nullptr, 0);
    }
    {
        const float* sw = a->in[21] + (size_t)l * 8 * 128 * 128; bf16_t* wsb = (bf16_t*)(ws + WS_WSB);
        for (int i = c.gtid; i < 8 * 128 * 128; i += c.NGT) { const int t = (i >> 7) & 127, s = i & 127; wsb[i] = (s <= t) ? (bf16_t)f2bf(sw[i]) : (bf16_t)0; }
    }
    {
        const float* p = a->in[1] + (size_t)l * M * PLE; bf16_t* pb = (bf16_t*)(ws + WS_PB);
        for (int i = c.gtid; i < M * PLE / 4; i += c.NGT) { const f32x4 v = *(const f32x4*)(p + 4 * (size_t)i); const int m = i >> 6, cc = (i & 63) * 4;
            u32x2 w; w.x = pk2(v[0], v[1]); w.y = pk2(v[2], v[3]); *(u32x2*)(pb + (size_t)m * 2048 + cc) = w; }
    }
}

__device__ __forceinline__ void phase_init(const Ctx& c, ArgsP a) {
    const float* xin = a->in[0]; bf16_t* XB = (bf16_t*)(a->ws + WS_XN); unsigned char* XL = a->ws + WS_XLO; float* SS = (float*)(a->ws + WS_SS);
    for (int m = c.gw; m < M; m += c.NGW) {
        float ss = 0.f;
#pragma unroll
        for (int j = 0; j < 8; ++j) { const size_t o = (size_t)m * D + 256 * j + 4 * c.lane; const f32x4 x = *(const f32x4*)(xin + o);
            u32x2 w; w.x = pk2(x[0], x[1]); w.y = pk2(x[2], x[3]); *(u32x2*)(XB + o) = w;
            *(unsigned*)(XL + o) = lo8_pack(x[0] - bflo(w.x), x[1] - bfhi(w.x), x[2] - bflo(w.y), x[3] - bfhi(w.y));
            ss += (x[0] * x[0] + x[1] * x[1]) + (x[2] * x[2] + x[3] * x[3]); }
        ss = wave_sum(ss);
        if (c.lane < 32) SS[(size_t)m * 32 + c.lane] = (c.lane == 0) ? ss : 0.f;
    }
}

typedef short s16x4 __attribute__((ext_vector_type(4)));
constexpr int ATT_K_OFF = 0, ATT_V_OFF = 65536, ATT_RK_OFF = 132096;
struct AttItem { int b, h, g, r, nb, dsh, rowb; };
__device__ __forceinline__ AttItem att_decode(int it) {
    AttItem t; t.h = it & 7; const int rest = it >> 3, q48 = rest % 192, span = q48 / 48, jj = q48 % 48, e16 = jj & 15;
    t.b = rest / 192; t.g = jj >> 4; t.dsh = 2 * t.g; t.rowb = t.b * SEQ;
    t.r = (t.g == 0) ? 0 : (t.g == 1 ? (e16 & 3) : e16); t.nb = (t.g == 0) ? span * 16 + e16 : (t.g == 1 ? span * 4 + (e16 >> 2) : span);
    return t;
}
template <int VT> __device__ __forceinline__ void att_dma(const bf16_t* P, const AttItem& t, LAS unsigned char* lds, int w, int lane) {
#pragma unroll
    for (int i = 0; i < 8; ++i) {
        const int q = w * 8 + i, trow = 4 * q + (lane >> 4), pc = lane & 15;
        int pos = ((128 * (t.nb - 1) + trow) << t.dsh) + t.r; if (pos < 0) pos = t.r;
        const bf16_t* src = P + (size_t)(t.rowb + pos) * NIN + t.h * 128;
        if (VT == 0) __builtin_amdgcn_global_load_lds((const unsigned*)(src + C_K + ((pc ^ (trow & 15)) << 3)), (LAS unsigned*)(lds + ATT_K_OFF + q * 1024), 16, 0, 0);
        else         __builtin_amdgcn_global_load_lds((const unsigned*)(src + C_V + ((pc ^ ((trow & 7) << 1)) << 3)), (LAS unsigned*)(lds + ATT_V_OFF + q * 1024), 16, 0, 0);
    }
}
constexpr int ATT_GT_OFF = 133120;
__device__ __forceinline__ void att_qprep(const u32x4 (&qraw)[4], LAS unsigned char* lds, int kq, bf16x8 (&qf)[4], float& rq) {
    float ssq = 0.f;
#pragma unroll
    for (int ks = 0; ks < 4; ++ks) {
        const u32x4 qr = qraw[ks];
        const f32x4 ga = *(const LAS f32x4*)(lds + ATT_GT_OFF + (32 * ks + 8 * kq) * 4), gb = *(const LAS f32x4*)(lds + ATT_GT_OFF + (32 * ks + 8 * kq + 4) * 4);
        u32x4 o; float lo, hi;
        lo = bflo(qr[0]); hi = bfhi(qr[0]); ssq += lo * lo + hi * hi; o[0] = pk2(lo * ga[0], hi * ga[1]);
        lo = bflo(qr[1]); hi = bfhi(qr[1]); ssq += lo * lo + hi * hi; o[1] = pk2(lo * ga[2], hi * ga[3]);
        lo = bflo(qr[2]); hi = bfhi(qr[2]); ssq += lo * lo + hi * hi; o[2] = pk2(lo * gb[0], hi * gb[1]);
        lo = bflo(qr[3]); hi = bfhi(qr[3]); ssq += lo * lo + hi * hi; o[3] = pk2(lo * gb[2], hi * gb[3]);
        qf[ks] = __builtin_bit_cast(bf16x8, o);
    }
    ssq += __shfl_xor(ssq, 16); ssq += __shfl_xor(ssq, 32);
    rq = rsqrtf(ssq * (1.0f / 128.0f) + EPS);
}
#define ATT_BAR() do { asm volatile("s_waitcnt lgkmcnt(0)" ::: "memory"); __builtin_amdgcn_s_barrier(); asm volatile("" ::: "memory"); } while (0)
__device__ __forceinline__ void phase_attn(const Ctx& c, ArgsP a, int l) {
    const bf16_t* P = (const bf16_t*)(a->ws + WS_PROJ); bf16_t* OG = (bf16_t*)(a->ws + WS_OG); float* LSE = (float*)(a->ws + WS_LSE);
    const float* qg = a->in[18] + (size_t)l * 128; const float* kg = a->in[19] + (size_t)l * 128;
    const int w = c.wave, lane = c.lane, n = lane & 15, kq = lane >> 4;
    LAS unsigned char* lds = c.lds;
    int it = c.bid; if (it >= 3072) return;
    if (c.tid < 128) *(LAS float*)(lds + ATT_GT_OFF + c.tid * 4) = qg[c.tid] * kg[c.tid] * 0.08838834764831845f;
    ATT_BAR();
    AttItem cur = att_decode(it);
    u32x4 qraw[4]; bf16x8 qf[4]; float rq;
    att_dma<0>(P, cur, lds, w, lane);
    { const size_t qrow0 = (size_t)cur.rowb + (((128 * cur.nb + 16 * w + n) << cur.dsh) + cur.r);
#pragma unroll
      for (int ks = 0; ks < 4; ++ks) qraw[ks] = *(const u32x4*)(P + qrow0 * NIN + C_Q + (cur.g * 8 + cur.h) * 128 + 32 * ks + 8 * kq); }
    asm volatile("s_waitcnt vmcnt(0)" ::: "memory");
    att_qprep(qraw, lds, kq, qf, rq);
    for (;;) {
        const int itn = it + c.gdim; const bool has_next = itn < 3072; const AttItem nxt = att_decode(has_next ? itn : it);
        const int h = cur.h, g = cur.g, nb = cur.nb;
        const size_t qrow = (size_t)cur.rowb + (((128 * nb + 16 * w + n) << cur.dsh) + cur.r);
        ATT_BAR();
        att_dma<1>(P, cur, lds, w, lane);
        {
            const int krow = c.tid >> 1, hf = c.tid & 1; float s = 0.f;
#pragma unroll
            for (int cc = 0; cc < 8; ++cc) { const u32x4 kv = *(const LAS u32x4*)(lds + ATT_K_OFF + krow * 256 + ((hf * 8 + cc) << 4));
#pragma unroll
                for (int e = 0; e < 4; ++e) { const float lo = bflo(kv[e]), hi = bfhi(kv[e]); s += lo * lo + hi * hi; } }
            s += __shfl_xor(s, 1);
            if (hf == 0) *(LAS float*)(lds + ATT_RK_OFF + krow * 4) = rsqrtf(s * (1.0f / 128.0f) + EPS);
        }
        f32x4 st[9];
#pragma unroll
        for (int T = 0; T < 9; ++T) {
            f32x4 acc = (f32x4){0.f, 0.f, 0.f, 0.f};
#pragma unroll
            for (int ks = 0; ks < 4; ++ks) {
                const bf16x8 kf = *(const LAS bf16x8*)(lds + ATT_K_OFF + (16 * (w + T) + n) * 256 + (((4 * ks + kq) ^ n) << 4));
                acc = __builtin_amdgcn_mfma_f32_16x16x32_bf16(kf, qf[ks], acc, 0, 0, 0);
            }
            st[T] = acc;
        }
        ATT_BAR();
        if (has_next) {
            const size_t qrown = (size_t)nxt.rowb + (((128 * nxt.nb + 16 * w + n) << nxt.dsh) + nxt.r);
#pragma unroll
            for (int ks = 0; ks < 4; ++ks) qraw[ks] = *(const u32x4*)(P + qrown * NIN + C_Q + (nxt.g * 8 + nxt.h) * 128 + 32 * ks + 8 * kq);
            att_dma<0>(P, nxt, lds, w, lane);
        }
        float mx = -1e30f;
#pragma unroll
        for (int T = 0; T < 9; ++T) {
            const f32x4 rk4 = *(const LAS f32x4*)(lds + ATT_RK_OFF + (16 * (w + T) + 4 * kq) * 4);
#pragma unroll
            for (int e = 0; e < 4; ++e) {
                const int kl = 16 * T + 4 * kq + e;
                const bool valid = (kl >= n) && (kl <= n + 128) && (nb > 0 || 16 * w + kl >= 128);
                const float s = valid ? st[T][e] * rk4[e] * rq : -1e30f;
                st[T][e] = s; mx = fmaxf(mx, s);
            }
        }
        mx = fmaxf(mx, __shfl_xor(mx, 16)); mx = fmaxf(mx, __shfl_xor(mx, 32));
        float sum = 0.f;
#pragma unroll
        for (int T = 0; T < 9; ++T)
#pragma unroll
            for (int e = 0; e < 4; ++e) { const float p = (st[T][e] > -1e29f) ? __expf(st[T][e] - mx) : 0.f; st[T][e] = p; sum += p; }
        sum += __shfl_xor(sum, 16); sum += __shfl_xor(sum, 32);
        if (has_next) asm volatile("s_waitcnt vmcnt(8)" ::: "memory"); else asm volatile("s_waitcnt vmcnt(0)" ::: "memory");
        ATT_BAR();
        f32x4 oacc[8];
#pragma unroll
        for (int dt = 0; dt < 8; ++dt) oacc[dt] = (f32x4){0.f, 0.f, 0.f, 0.f};
#pragma unroll
        for (int p = 0; p < 5; ++p) {
            const int T0 = 2 * p, T1 = (2 * p + 1 <= 8) ? 2 * p + 1 : 8;
            u32x4 pw; pw[0] = pk2(st[T0][0], st[T0][1]); pw[1] = pk2(st[T0][2], st[T0][3]);
            if (2 * p + 1 <= 8) { pw[2] = pk2(st[T1][0], st[T1][1]); pw[3] = pk2(st[T1][2], st[T1][3]); } else { pw[2] = 0u; pw[3] = 0u; }
            const bf16x8 pf = __builtin_bit_cast(bf16x8, pw);
            const int vr0 = 16 * (w + T0) + 4 * kq + (n >> 2), vr1 = 16 * (w + T1) + 4 * kq + (n >> 2);
#pragma unroll
            for (int dt = 0; dt < 8; ++dt) {
                const int ch = 2 * dt + ((lane & 3) >> 1);
                const s16x4 v0 = __builtin_amdgcn_ds_read_tr16_b64_v4i16((LAS s16x4*)(lds + ATT_V_OFF + vr0 * 256 + ((ch ^ ((vr0 & 7) << 1)) << 4) + (lane & 1) * 8));
                const s16x4 v1 = __builtin_amdgcn_ds_read_tr16_b64_v4i16((LAS s16x4*)(lds + ATT_V_OFF + vr1 * 256 + ((ch ^ ((vr1 & 7) << 1)) << 4) + (lane & 1) * 8));
                const bf16x8 vf = (bf16x8){v0[0], v0[1], v0[2], v0[3], v1[0], v1[1], v1[2], v1[3]};
                oacc[dt] = __builtin_amdgcn_mfma_f32_16x16x32_bf16(vf, pf, oacc[dt], 0, 0, 0);
            }
        }
        asm volatile("s_waitcnt vmcnt(0)" ::: "memory");
        const float inv = 1.0f / sum; const float lse = mx + __logf(sum);
        if (has_next) att_qprep(qraw, lds, kq, qf, rq);
        bf16_t* op = OG + ((size_t)g * M + qrow) * 1024 + h * 128 + 4 * kq;
#pragma unroll
        for (int dt = 0; dt < 8; ++dt) { u32x2 o; o.x = pk2(oacc[dt][0] * inv, oacc[dt][1] * inv); o.y = pk2(oacc[dt][2] * inv, oacc[dt][3] * inv); *(u32x2*)(op + 16 * dt) = o; }
        if (kq == 0) LSE[((size_t)g * M + qrow) * 8 + h] = lse;
        if (!has_next) break;
        cur = nxt; it = itn;
    }
}
#undef ATT_BAR
__device__ __forceinline__ void phase_attn_merge(const Ctx& c, ArgsP a) {
    const bf16_t* OG = (const bf16_t*)(a->ws + WS_OG); const float* LSE = (const float*)(a->ws + WS_LSE); bf16_t* Y2 = (bf16_t*)(a->ws + WS_Y) + (size_t)2 * M * 1024;
    for (size_t i0 = c.gtid; i0 < (size_t)M * 128; i0 += (size_t)4 * c.NGT) {
        float l0[4], l1[4], l2[4]; u32x4 a0[4], a1[4], a2[4];
#pragma unroll
        for (int k = 0; k < 4; ++k) { const size_t i = i0 + (size_t)k * c.NGT; const size_t m = i >> 7; const int c8 = (int)(i & 127) * 8, h = c8 >> 7;
            l0[k] = LSE[m * 8 + h]; l1[k] = LSE[((size_t)M + m) * 8 + h]; l2[k] = LSE[((size_t)2 * M + m) * 8 + h];
            a0[k] = *(const u32x4*)(OG + m * 1024 + c8); a1[k] = *(const u32x4*)(OG + ((size_t)M + m) * 1024 + c8); a2[k] = *(const u32x4*)(OG + ((size_t)2 * M + m) * 1024 + c8); }
#pragma unroll
        for (int k = 0; k < 4; ++k) { const size_t i = i0 + (size_t)k * c.NGT; const size_t m = i >> 7; const int c8 = (int)(i & 127) * 8;
            const float mm = fmaxf(l0[k], fmaxf(l1[k], l2[k])); float e0 = __expf(l0[k] - mm), e1 = __expf(l1[k] - mm), e2 = __expf(l2[k] - mm); const float inv = 1.0f / (e0 + e1 + e2); e0 *= inv; e1 *= inv; e2 *= inv;
            u32x4 o;
#pragma unroll
            for (int e = 0; e < 4; ++e) o[e] = pk2(e0 * bflo(a0[k][e]) + e1 * bflo(a1[k][e]) + e2 * bflo(a2[k][e]), e0 * bfhi(a0[k][e]) + e1 * bfhi(a1[k][e]) + e2 * bfhi(a2[k][e]));
            *(u32x4*)(Y2 + m * 1024 + c8) = o; }
    }
}

constexpr int A1_XC32 = 0, A1_XCB = 32768, A1_A32 = 49152, A1_U32 = 83968, A1_SUM = 118784;
#define A1_BAR() do { asm volatile("s_waitcnt lgkmcnt(0)" ::: "memory"); __builtin_amdgcn_s_barrier(); asm volatile("" ::: "memory"); } while (0)
#define A1_WSYNC() asm volatile("s_waitcnt lgkmcnt(0)" ::: "memory")
__device__ __forceinline__ void phase_a1(const Ctx& c, ArgsP a, int l) {
    const bf16_t* P = (const bf16_t*)(a->ws + WS_PROJ); const bf16_t* WGT = (const bf16_t*)(a->ws + WS_WGT);
    bf16_t* HL = (bf16_t*)(a->ws + WS_HL); bf16_t* AC = (bf16_t*)(a->ws + WS_AC); float* CSA = (float*)(a->ws + WS_CSA); float* CSH = (float*)(a->ws + WS_CSH);
    const float* cw = a->in[9] + (size_t)l * 4 * 1024; const float* cb = a->in[10] + (size_t)l * 1024;
    const float* ba = a->in[12] + (size_t)l * 1024; const float* bx = a->in[14] + (size_t)l * 1024; const float* lam = a->in[15] + (size_t)l * 1024;
    LAS unsigned char* lds = c.lds; const int tid = c.tid, lane = c.lane, w = c.wave, n = lane & 15, kq = lane >> 4;
    LAS float* XC32 = (LAS float*)(lds + A1_XC32); LAS float* A32 = (LAS float*)(lds + A1_A32); LAS float* U32 = (LAS float*)(lds + A1_U32); LAS float* SUM0 = (LAS float*)(lds + A1_SUM);
    unsigned short xr[19];
#define A1_LOAD(IT) do { const int chunk_ = (IT) >> 4, h_ = (IT) & 15, row0_ = chunk_ * 128, tseq0_ = row0_ & (SEQ - 1), r0_ = (tid >> 6) * 16; \
        const bf16_t* xp_ = P + (size_t)(row0_ + r0_) * NIN + C_XA + h_ * 64 + (tid & 63); \
        _Pragma("unroll") for (int j = 0; j < 19; ++j) xr[j] = (tseq0_ + r0_ + j - 3 >= 0) ? xp_[(ptrdiff_t)(j - 3) * NIN] : (unsigned short)0; } while (0)
    if (c.bid < 2048) A1_LOAD(c.bid);
    bf16x8 wfa[4][2], wfx[4][2]; float cw0 = 0.f, cw1 = 0.f, cw2 = 0.f, cw3 = 0.f, cbb = 0.f, gba[4], gbx[4], gsp[4]; int hcur = -1;
#pragma unroll
    for (int nt = 0; nt < 4; ++nt) { gba[nt] = 0.f; gbx[nt] = 0.f; gsp[nt] = 0.f;
#pragma unroll
        for (int ks = 0; ks < 2; ++ks) { wfa[nt][ks] = (bf16x8){0, 0, 0, 0, 0, 0, 0, 0}; wfx[nt][ks] = (bf16x8){0, 0, 0, 0, 0, 0, 0, 0}; } }
    int par = 0;
    for (int it = c.bid; it < 2048; it += c.gdim, par ^= 1) {
        const int chunk = it >> 4, h = it & 15, row0 = chunk * 128, tseq0 = row0 & (SEQ - 1);
        LAS float* SUM = SUM0 + par * 1024;
        if (h != hcur) { hcur = h;
#pragma unroll
            for (int nt = 0; nt < 4; ++nt) {
#pragma unroll
                for (int ks = 0; ks < 2; ++ks) { wfa[nt][ks] = *(const bf16x8*)(WGT + ((size_t)h * 64 + 16 * nt + n) * 64 + 32 * ks + 8 * kq);
                                                 wfx[nt][ks] = *(const bf16x8*)(WGT + ((size_t)(16 + h) * 64 + 16 * nt + n) * 64 + 32 * ks + 8 * kq); }
                const int gch = h * 64 + 16 * nt + n; const float lm = lam[gch]; gba[nt] = ba[gch]; gbx[nt] = bx[gch];
                gsp[nt] = (lm > 0.f ? 0.f : -lm) + __logf(1.0f + __expf(-fabsf(lm)));
            }
            const int gch = h * 64 + (tid & 63); cw0 = cw[gch]; cw1 = cw[1024 + gch]; cw2 = cw[2048 + gch]; cw3 = cw[3072 + gch]; cbb = cb[gch];
        }
        {
            const int ch = tid & 63, rg = tid >> 6, r0 = rg * 16;
            const float w0 = cw0, w1 = cw1, w2 = cw2, w3 = cw3, bb = cbb;
            float xm1 = bf2f(xr[2]), xm2 = bf2f(xr[1]), xm3 = bf2f(xr[0]);
#pragma unroll
            for (int r = 0; r < 16; ++r) {
                const float x0 = bf2f(xr[3 + r]);
                const float y = bb + w0 * x0 + w1 * xm1 + w2 * xm2 + w3 * xm3;
                const int row = r0 + r;
                XC32[row * 64 + ch] = y;
                *(LAS bf16_t*)(lds + A1_XCB + row * 128 + ((((ch >> 3) ^ (row & 7))) << 4) + (ch & 7) * 2) = (bf16_t)f2bf(y);
                xm3 = xm2; xm2 = xm1; xm1 = x0;
            }
        }
        A1_WSYNC();
        if (it + c.gdim < 2048) A1_LOAD(it + c.gdim);
        {
            bf16x8 af[2];
#pragma unroll
            for (int ks = 0; ks < 2; ++ks) af[ks] = *(const LAS bf16x8*)(lds + A1_XCB + (16 * w + n) * 128 + (((4 * ks + kq) ^ (n & 7)) << 4));
#pragma unroll
            for (int nt = 0; nt < 4; ++nt) {
                f32x4 aa = (f32x4){0.f, 0.f, 0.f, 0.f}, ax = (f32x4){0.f, 0.f, 0.f, 0.f};
#pragma unroll
                for (int ks = 0; ks < 2; ++ks) {
                    aa = __builtin_amdgcn_mfma_f32_16x16x32_bf16(af[ks], wfa[nt][ks], aa, 0, 0, 0);
                    ax = __builtin_amdgcn_mfma_f32_16x16x32_bf16(af[ks], wfx[nt][ks], ax, 0, 0, 0);
                }
                const int ch = 16 * nt + n; const float ba_ = gba[nt], bx_ = gbx[nt], sp = gsp[nt];
#pragma unroll
                for (int e = 0; e < 4; ++e) {
                    const int row = 16 * w + 4 * kq + e;
                    const float r = pg8::sig_f(aa[e] + ba_), ig = pg8::sig_f(ax[e] + bx_);
                    const float log_a = -8.0f * r * sp, av = __expf(log_a), z2 = 2.0f * log_a;
                    const float om = (z2 > -0.05f) ? -z2 * (1.0f + z2 * (0.5f + z2 * (0.16666667f + z2 * 0.041666668f))) : 1.0f - av * av;
                    A32[row * 68 + ch] = av; U32[row * 68 + ch] = __builtin_sqrtf(om) * (ig * XC32[row * 64 + ch]);
                }
            }
        }
        A1_WSYNC();
        const int ch = tid & 63, seg = tid >> 6, gch = h * 64 + ch;
        {
            float hh = 0.f, AA = 1.f;
#pragma unroll
            for (int r = 0; r < 16; ++r) { const int o = (seg * 16 + r) * 68 + ch; const float av = A32[o], uv = U32[o]; hh = av * hh + uv; AA *= av; A32[o] = AA; U32[o] = hh; }
            SUM[(seg * 64 + ch) * 2] = AA; SUM[(seg * 64 + ch) * 2 + 1] = hh;
        }
        A1_BAR();
        {
            float cin = 0.f, Ain = 1.f;
            for (int s2 = 0; s2 < seg; ++s2) { const float As = SUM[(s2 * 64 + ch) * 2], Hs = SUM[(s2 * 64 + ch) * 2 + 1]; cin = As * cin + Hs; Ain *= As; }
            float hl = 0.f, ac = 1.f;
#pragma unroll
            for (int r = 0; r < 16; ++r) { const int o = (seg * 16 + r) * 68 + ch; hl = U32[o] + A32[o] * cin; ac = A32[o] * Ain;
                const size_t go = (size_t)(row0 + seg * 16 + r) * 1024 + gch; HL[go] = (bf16_t)f2bf(hl); AC[go] = (bf16_t)f2bf(ac); }
            if (seg == 7) { CSA[chunk * 1024 + gch] = ac; CSH[chunk * 1024 + gch] = hl; }
        }
    }
}
#undef A1_BAR
#undef A1_WSYNC
#undef A1_LOAD
__device__ __forceinline__ void phase_carry(const Ctx& c, ArgsP a) {
    const float* CSA = (const float*)(a->ws + WS_CSA); const float* CSH = (const float*)(a->ws + WS_CSH); float* CIN = (float*)(a->ws + WS_CIN);
    for (int w = c.gw; w < 2 * 1024; w += c.NGW) {
        const int b = w >> 10, gch = w & 1023, chunk = b * 64 + c.lane;
        float A = CSA[chunk * 1024 + gch], H = CSH[chunk * 1024 + gch];
#pragma unroll
        for (int o = 1; o < 64; o <<= 1) {
            const float Ap = __shfl_up(A, o), Hp = __shfl_up(H, o);
            if (c.lane >= o) { H = A * Hp + H; A = A * Ap; }
        }
        const float hin = __shfl_up(H, 1);
        CIN[chunk * 1024 + gch] = (c.lane == 0) ? 0.f : hin;
    }
}
__device__ __forceinline__ void phase_a3(const Ctx& c, ArgsP a) {
    const bf16_t* HL = (const bf16_t*)(a->ws + WS_HL); const bf16_t* AC = (const bf16_t*)(a->ws + WS_AC); const float* CIN = (const float*)(a->ws + WS_CIN);
    const bf16_t* P = (const bf16_t*)(a->ws + WS_PROJ); bf16_t* Y0 = (bf16_t*)(a->ws + WS_Y);
    for (int i = c.gtid; i < 128 * 8 * 128; i += c.NGT) {
        const int c8 = (i & 127) * 8, rg = (i >> 7) & 7, chunk = i >> 10;
        const f32x4 ca = *(const f32x4*)(CIN + chunk * 1024 + c8), cb = *(const f32x4*)(CIN + chunk * 1024 + c8 + 4);
#pragma unroll 1
        for (int r0 = 0; r0 < 16; r0 += 8) {
            u32x4 hl[8], ac[8], ga[8];
#pragma unroll
            for (int r = 0; r < 8; ++r) { const size_t row = (size_t)chunk * 128 + rg * 16 + r0 + r; hl[r] = *(const u32x4*)(HL + row * 1024 + c8); ac[r] = *(const u32x4*)(AC + row * 1024 + c8); ga[r] = *(const u32x4*)(P + row * NIN + C_GA + c8); }
#pragma unroll
            for (int r = 0; r < 8; ++r) { const size_t row = (size_t)chunk * 128 + rg * 16 + r0 + r; u32x4 o;
                o[0] = pk2((bflo(hl[r][0]) + bflo(ac[r][0]) * ca[0]) * bflo(ga[r][0]), (bfhi(hl[r][0]) + bfhi(ac[r][0]) * ca[1]) * bfhi(ga[r][0]));
                o[1] = pk2((bflo(hl[r][1]) + bflo(ac[r][1]) * ca[2]) * bflo(ga[r][1]), (bfhi(hl[r][1]) + bfhi(ac[r][1]) * ca[3]) * bfhi(ga[r][1]));
                o[2] = pk2((bflo(hl[r][2]) + bflo(ac[r][2]) * cb[0]) * bflo(ga[r][2]), (bfhi(hl[r][2]) + bfhi(ac[r][2]) * cb[1]) * bfhi(ga[r][2]));
                o[3] = pk2((bflo(hl[r][3]) + bflo(ac[r][3]) * cb[2]) * bflo(ga[r][3]), (bfhi(hl[r][3]) + bfhi(ac[r][3]) * cb[3]) * bfhi(ga[r][3]));
                *(u32x4*)(Y0 + row * 1024 + c8) = o; }
        }
    }
}

__device__ __forceinline__ void phase_pool(const Ctx& c, ArgsP a) {
    const bf16_t* P = (const bf16_t*)(a->ws + WS_PROJ); bf16_t* PL = (bf16_t*)(a->ws + WS_PL);
    for (int i = c.gtid; i < (M / 64) * 512; i += c.NGT) {
        const int blk = i >> 9, ch = (i & 511) * 2, win = 2 << (ch >> 8), row0 = blk * 64, tseq0 = row0 & (SEQ - 1); const float rwin = 1.0f / (float)win;
        const bf16_t* xp = P + (size_t)row0 * NIN + C_XB + ch;
        float ra[16], rb[16]; float sa = 0.f, sb = 0.f;
#pragma unroll
        for (int j = 0; j < 16; ++j) { const int back = 16 - j;
            unsigned w = 0u; if (back < win && tseq0 - back >= 0) w = *(const unsigned*)(xp - (ptrdiff_t)back * NIN);
            ra[j] = bflo(w); rb[j] = bfhi(w); sa += ra[j]; sb += rb[j]; }
#pragma unroll 1
        for (int r0 = 0; r0 < 64; r0 += 32) {
            unsigned w[32];
#pragma unroll
            for (int j = 0; j < 32; ++j) w[j] = *(const unsigned*)(xp + (size_t)(r0 + j) * NIN);
#pragma unroll
            for (int j = 0; j < 32; ++j) {
                const int r = r0 + j; const float xa = bflo(w[j]), xb = bfhi(w[j]);
                const float ta = sa + xa, tb = sb + xb; const int tq = tseq0 + r; const float rc = (tq + 1 < win) ? 1.0f / (float)(tq + 1) : rwin;
                *(unsigned*)(PL + (size_t)(row0 + r) * 1024 + ch) = pk2(ta * rc - xa, tb * rc - xb);
                const float da = (win == 2) ? ra[(j + 15) & 15] : (win == 4) ? ra[(j + 13) & 15] : (win == 8) ? ra[(j + 9) & 15] : ra[(j + 1) & 15];
                const float db = (win == 2) ? rb[(j + 15) & 15] : (win == 4) ? rb[(j + 13) & 15] : (win == 8) ? rb[(j + 9) & 15] : rb[(j + 1) & 15];
                sa = ta - da; sb = tb - db; ra[j & 15] = xa; rb[j & 15] = xb;
            }
        }
    }
}

#define SG_BAR() do { asm volatile("s_waitcnt lgkmcnt(0)" ::: "memory"); __builtin_amdgcn_s_barrier(); asm volatile("" ::: "memory"); } while (0)
__device__ __forceinline__ void phase_sg(const Ctx& c, ArgsP a, int l) {
    const bf16_t* P = (const bf16_t*)(a->ws + WS_PROJ); const bf16_t* WSB = (const bf16_t*)(a->ws + WS_WSB); const float* SSV = (const float*)(a->ws + WS_SSV);
    bf16_t* Y3 = (bf16_t*)(a->ws + WS_Y) + (size_t)3 * M * 1024;
    const float* sgn = a->in[20] + (size_t)l * 1024; const float* sgb = a->in[22] + (size_t)l * 8 * 128;
    LAS unsigned char* lds = c.lds; const int tid = c.tid, lane = c.lane, w = c.wave, n = lane & 15, kq = lane >> 4;
    if (c.bid >= 1024) return;
    const int sr = tid >> 2, sq = tid & 3;
    u32x4 zv[4]; f32x4 ssp[4]; u32x2 uu[8];
#define SG_LOAD(IT) do { const int row0_ = ((IT) >> 3) * 128, g_ = (IT) & 7; const size_t row_ = (size_t)row0_ + sr; \
        _Pragma("unroll") for (int i_ = 0; i_ < 4; ++i_) { ssp[i_] = *(const f32x4*)(SSV + row_ * 16 + 4 * i_); zv[i_] = *(const u32x4*)(P + row_ * NIN + C_ZV + g_ * 128 + (4 * sq + i_) * 8); } \
        _Pragma("unroll") for (int ct_ = 0; ct_ < 8; ++ct_) uu[ct_] = *(const u32x2*)(P + ((size_t)row0_ + 16 * w + n) * NIN + C_ZU + g_ * 128 + 16 * ct_ + 4 * kq); } while (0)
    SG_LOAD(c.bid);
    int gcur = -1; bf16x8 wfa[4]; f32x4 gn[4][2]; float bt = 0.f;
    for (int it = c.bid; it < 1024; it += c.gdim) {
        const int chunk = it >> 3, g = it & 7, row0 = chunk * 128;
        if (g != gcur) {
            gcur = g;
#pragma unroll
            for (int ks = 0; ks < 4; ++ks) wfa[ks] = *(const bf16x8*)(WSB + ((size_t)g * 128 + 16 * w + n) * 128 + 32 * ks + 8 * kq);
#pragma unroll
            for (int cc = 0; cc < 4; ++cc) { gn[cc][0] = *(const f32x4*)(sgn + g * 128 + (4 * sq + cc) * 8); gn[cc][1] = *(const f32x4*)(sgn + g * 128 + (4 * sq + cc) * 8 + 4); }
            bt = sgb[g * 128 + 16 * w + n];
        }
        {
            const float ss = (((ssp[0][0] + ssp[0][1]) + (ssp[0][2] + ssp[0][3])) + ((ssp[1][0] + ssp[1][1]) + (ssp[1][2] + ssp[1][3]))) + (((ssp[2][0] + ssp[2][1]) + (ssp[2][2] + ssp[2][3])) + ((ssp[3][0] + ssp[3][1]) + (ssp[3][2] + ssp[3][3])));
            const float rs = rsqrtf(ss * (1.0f / 1024.0f) + EPS);
#pragma unroll
            for (int cc = 0; cc < 4; ++cc) {
                const int chn = 4 * sq + cc;
                const u32x4 v = zv[cc]; const f32x4 g0 = gn[cc][0], g1 = gn[cc][1];
                u32x4 o; o[0] = pk2(bflo(v[0]) * rs * g0[0], bfhi(v[0]) * rs * g0[1]); o[1] = pk2(bflo(v[1]) * rs * g0[2], bfhi(v[1]) * rs * g0[3]);
                o[2] = pk2(bflo(v[2]) * rs * g1[0], bfhi(v[2]) * rs * g1[1]); o[3] = pk2(bflo(v[3]) * rs * g1[2], bfhi(v[3]) * rs * g1[3]);
                *(LAS u32x4*)(lds + sr * 256 + ((chn ^ ((sr & 7) << 1)) << 4)) = o;
            }
        }
        u32x2 ucur[8];
#pragma unroll
        for (int ct = 0; ct < 8; ++ct) ucur[ct] = uu[ct];
        SG_BAR();
        if (it + c.gdim < 1024) SG_LOAD(it + c.gdim);
        f32x4 acc[8];
#pragma unroll
        for (int ct = 0; ct < 8; ++ct) acc[ct] = (f32x4){0.f, 0.f, 0.f, 0.f};
        const int nks = (w >> 1) + 1;
#pragma unroll
        for (int ks = 0; ks < 4; ++ks) { if (ks >= nks) break;
            const bf16x8 wf = wfa[ks];
            const int sr0 = 32 * ks + 8 * kq + (n >> 2), sr1 = sr0 + 4;
#pragma unroll
            for (int ct = 0; ct < 8; ++ct) {
                const int chn = 2 * ct + ((lane & 3) >> 1);
                const s16x4 v0 = __builtin_amdgcn_ds_read_tr16_b64_v4i16((LAS s16x4*)(lds + sr0 * 256 + ((chn ^ ((sr0 & 7) << 1)) << 4) + (lane & 1) * 8));
                const s16x4 v1 = __builtin_amdgcn_ds_read_tr16_b64_v4i16((LAS s16x4*)(lds + sr1 * 256 + ((chn ^ ((sr1 & 7) << 1)) << 4) + (lane & 1) * 8));
                const bf16x8 vf = (bf16x8){v0[0], v0[1], v0[2], v0[3], v1[0], v1[1], v1[2], v1[3]};
                acc[ct] = __builtin_amdgcn_mfma_f32_16x16x32_bf16(vf, wf, acc[ct], 0, 0, 0);
            }
        }
        {
            const int t = 16 * w + n; const size_t row = (size_t)row0 + t;
#pragma unroll
            for (int ct = 0; ct < 8; ++ct) {
                const int col = g * 128 + 16 * ct + 4 * kq;
                u32x2 o; o.x = pk2(bflo(ucur[ct].x) * (acc[ct][0] + bt), bfhi(ucur[ct].x) * (acc[ct][1] + bt)); o.y = pk2(bflo(ucur[ct].y) * (acc[ct][2] + bt), bfhi(ucur[ct].y) * (acc[ct][3] + bt));
                *(u32x2*)(Y3 + row * 1024 + col) = o;
            }
        }
        SG_BAR();
    }
}
#undef SG_BAR
#undef SG_LOAD

#define XB_TMO      128
#define XB_XCNT(j)  (256  + 64 * (j))
#define XB_XSUB(j)  (1280 + 64 * (j))
#define XB_XGEN(j)  (2304 + 64 * (j))
#define XB_TOP      3328
#define XB_TOPGEN   3392
#define XCD_BAR_WORDS 3456
#define XB_SPIN_CAP (1u << 18)

__device__ __forceinline__ unsigned xb_ld(unsigned* p)              { return __hip_atomic_load(p, __ATOMIC_RELAXED, __HIP_MEMORY_SCOPE_AGENT); }
__device__ __forceinline__ unsigned xb_add(unsigned* p, unsigned v) { return __hip_atomic_fetch_add(p, v, __ATOMIC_RELAXED, __HIP_MEMORY_SCOPE_AGENT); }
__device__ __forceinline__ unsigned xb_xcc_id() { return (unsigned)__builtin_amdgcn_s_getreg((3 << 11) | 20) & 0xFu; }
#define XB_SPIN(cond, bar) do { unsigned _sp = 0; while (cond) { __builtin_amdgcn_s_sleep(1); \
    if ((++_sp & 255u) == 0u) { if (xb_ld(&(bar)[XB_TMO])) break; if (_sp > XB_SPIN_CAP) { atomicAdd(&(bar)[XB_TMO], 1u); break; } } } } while (0)

struct XcdBarrier {
    unsigned* bar; unsigned x;
    volatile LAS unsigned* st;
};

__device__ __forceinline__ XcdBarrier xcd_barrier_post(unsigned* bar, volatile LAS unsigned* st) {
    XcdBarrier b; b.bar = bar; b.x = xb_xcc_id(); b.st = st;
    if (threadIdx.x == 0) (void)xb_add(&bar[XB_XCNT(b.x)], 1u);
    return b;
}
__device__ __forceinline__ void xcd_barrier_complete(unsigned* bar, unsigned x, unsigned& nloc, unsigned& nx) {
    const unsigned G = gridDim.x * gridDim.y * gridDim.z;
    unsigned sum, cnt, mine, sp = 0u;
    for (;;) {
        sum = 0u; cnt = 0u; mine = 0u;
#pragma unroll
        for (unsigned j = 0; j < 16; ++j) { const unsigned c = xb_ld(&bar[XB_XCNT(j)]); sum += c; cnt += (c > 0u) ? 1u : 0u; mine = (j == x) ? c : mine; }
        if (sum == G) break;
        __builtin_amdgcn_s_sleep(1);
        if ((++sp & 255u) == 0u) { if (xb_ld(&bar[XB_TMO])) break; if (sp > XB_SPIN_CAP) { atomicAdd(&bar[XB_TMO], 1u); break; } }
    }
    nloc = mine > 0u ? mine : 1u; nx = cnt > 0u ? cnt : 1u;
}

__device__ __forceinline__ void xcd_barrier(const XcdBarrier& b) {
    asm volatile("s_waitcnt vmcnt(0)" ::: "memory");
    __syncthreads();
    if (threadIdx.x == 0) {
        unsigned* bar = b.bar;
        __builtin_amdgcn_s_waitcnt(0);
        unsigned nloc = b.st[0], nx = b.st[1];
        if (nloc == 0u) { xcd_barrier_complete(bar, b.x, nloc, nx); b.st[0] = nloc; b.st[1] = nx; }
        const unsigned old = xb_add(&bar[XB_XSUB(b.x)], 1u);
        const unsigned gen = old / nloc;
        if (old + 1u == (gen + 1u) * nloc) {
            __builtin_amdgcn_fence(__ATOMIC_RELEASE, "agent");
            asm volatile("s_waitcnt vmcnt(0)" ::: "memory");
            const unsigned og = xb_add(&bar[XB_TOP], 1u);
            const unsigned tg = og / nx;
            if (og + 1u == (tg + 1u) * nx) xb_add(&bar[XB_TOPGEN], 1u);
            else XB_SPIN(xb_ld(&bar[XB_TOPGEN]) == tg, bar);
            __builtin_amdgcn_fence(__ATOMIC_ACQUIRE, "agent");
            xb_add(&bar[XB_XGEN(b.x)], 1u);
            asm volatile("s_waitcnt vmcnt(0)" ::: "memory");
        } else {
            XB_SPIN(xb_ld(&bar[XB_XGEN(b.x)]) == gen, bar);
            __builtin_amdgcn_fence(__ATOMIC_ACQUIRE, "agent");
            asm volatile("s_waitcnt vmcnt(0)" ::: "memory");
        }
    }
    __syncthreads();
}

constexpr int LDS_BYTES = 147456;
constexpr int MISC_OFF = 131072 + 320;
constexpr int CW_BAR = 4096;
constexpr size_t CTL_ZERO_BYTES = 256 * 1024;

__global__ void __launch_bounds__(NTHR, 2) mk_fwd(Args args) {
    extern __shared__ __attribute__((aligned(16))) unsigned char lds_raw[];
    LAS unsigned char* const lds = (LAS unsigned char*)lds_raw;
    volatile LAS unsigned* MISC = (volatile LAS unsigned*)(lds + MISC_OFF);
    if (threadIdx.x < 32) MISC[threadIdx.x] = 0u;
    __syncthreads();
    (void)xcd_barrier_post((unsigned*)(args.ws + WS_CTL) + CW_BAR, MISC + 8);
    const ArgsP argp0 = (ArgsP)__builtin_amdgcn_kernarg_segment_ptr();
    const int s_lo = args.s_lo, s_hi = args.s_hi;
    int s = 0;
#define STEP_BEGIN if (s_lo <= s && s < s_hi) { \
    int tid_ = threadIdx.x, l_ = l; asm volatile("" : "+v"(tid_)); asm volatile("" : "+s"(l_)); ArgsP ap = argp0; asm volatile("" : "+s"(ap)); int bid_ = blockIdx.x, gdim_ = gridDim.x; asm volatile("" : "+s"(bid_)); asm volatile("" : "+s"(gdim_)); \
    Ctx c; c.lds = lds; c.tid = tid_; c.lane = tid_ & 63; c.wave = __builtin_amdgcn_readfirstlane(tid_ >> 6); \
    c.bid = bid_; c.gdim = gdim_; c.gw = bid_ * NWAVES + c.wave; c.NGW = gdim_ * NWAVES; c.gtid = bid_ * NTHR + c.tid; c.NGT = gdim_ * NTHR; \
    unsigned char* ws = ap->ws; float* X = ap->out; bf16_t* XN = (bf16_t*)(ws + ((l_ & 1) ? WS_XN2 : WS_XN)); bf16_t* XNnext = (bf16_t*)(ws + ((l_ & 1) ? WS_XN : WS_XN2)); unsigned char* XLO = ws + WS_XLO; \
    bf16_t* PROJ = (bf16_t*)(ws + WS_PROJ); bf16_t* H = (bf16_t*)(ws + WS_H); bf16_t* Y = (bf16_t*)(ws + WS_Y); \
    float* SS = (float*)(ws + WS_SS); \
    (void)X; (void)XN; (void)XNnext; (void)XLO; (void)PROJ; (void)H; (void)Y; (void)l_; (void)SS;
#define STEP_END   if (s + 1 < s_hi) { XcdBarrier bb; bb.bar = (unsigned*)(ap->ws + WS_CTL) + CW_BAR; asm volatile("" : "+s"(bb.bar)); bb.x = xb_xcc_id(); asm volatile("" : "+s"(bb.x)); \
        bb.st = (volatile LAS unsigned*)(lds + MISC_OFF) + 8; xcd_barrier(bb); } } ++s;

    for (int l = 0; l < NL; ++l) {
        STEP_BEGIN
            phase_prep(c, ap, l_);
            if (l_ == 0) phase_init(c, ap);
        STEP_END
        for (int f = 0; f < 2; ++f) {
            STEP_BEGIN
                pg8::Gemm g{XN, (const bf16_t*)(ws + (f ? WS_W13B : WS_W13A)), 0, 0, M, 2 * F, D, D, D, 1, 0, 0}; pg8::EpiUp E{H, SS + (size_t)(l_ * 4 + 2 * f) * M * 32};
                pg8::StaticOrder S; S.init(g.M, g.N, g.nS, gdim_, bid_);
                pg8::gemm_phase<pg8::EpiUp, pg8::StaticOrder>(c.lds, g, S, E);
            STEP_END
            STEP_BEGIN
                pg8::Gemm g{H, (const bf16_t*)(ws + (f ? WS_W2B : WS_W2A)), 0, 0, M, D, F, F, F, 1, 0, 0}; pg8::EpiRes E{XN, XN, XLO, nullptr, SS + (size_t)(l_ * 4 + 2 * f + 1) * M * 32, nullptr, nullptr, 0.5f, 0};
                pg8::StaticOrder S; S.init(g.M, g.N, g.nS, gdim_, bid_, 1);
                pg8::gemm_phase<pg8::EpiRes, pg8::StaticOrder>(c.lds, g, S, E);
            STEP_END
            if (f == 0) {
                STEP_BEGIN
                    pg8::Gemm g{XN, (const bf16_t*)(ws + WS_WIN), 0, 0, M, NIN, D, D, D, 1, 0, 0}; pg8::EpiIn E{PROJ, SS + (size_t)(l_ * 4 + 1) * M * 32, (float*)(ws + WS_SSV), ap->in[8] + (size_t)l_ * 4 * D};
                    pg8::StaticOrder S; S.init(g.M, g.N, g.nS, gdim_, bid_);
                    pg8::gemm_phase<pg8::EpiIn, pg8::StaticOrder>(c.lds, g, S, E);
                STEP_END
                STEP_BEGIN
                    phase_attn(c, ap, l_);
                    phase_sg(c, ap, l_);
                    phase_a1(c, ap, l_);
                    phase_pool(c, ap);
                STEP_END
                STEP_BEGIN
                    pg8::Gemm g{(const bf16_t*)(ws + WS_PL), (const bf16_t*)(ws + WS_WPOOL), 256, 256 * 256, M, 256, 256, 1024, 256, 4, 0, 0};
                    pg8::EpiPlain E{Y + (size_t)1 * M * 1024, 1024, 256};
                    pg8::StaticOrder S; S.init(g.M, g.N, g.nS, gdim_, bid_);
                    pg8::gemm_phase<pg8::EpiPlain, pg8::StaticOrder>(c.lds, g, S, E);
                    phase_carry(c, ap);
                STEP_END
                STEP_BEGIN
                    phase_a3(c, ap);
                    phase_attn_merge(c, ap);
                STEP_END
                STEP_BEGIN
                    pg8::Gemm g{Y, (const bf16_t*)(ws + WS_WBR), (size_t)M * 1024, (size_t)D * 1024, M, D, 1024, 1024, 1024, 1, 0, 0}; pg8::EpiBr E{PROJ + C_GATE, (bf16_t*)(ws + WS_MRGB)};
                    pg8::BrOrder S; S.so.init(g.M, g.N, 1, gdim_, bid_, 1);
                    pg8::gemm_phase<pg8::EpiBr, pg8::BrOrder>(c.lds, g, S, E);
                STEP_END
                STEP_BEGIN
                    pg8::Gemm g{(const bf16_t*)(ws + WS_MRGB), (const bf16_t*)(ws + WS_WOUT), 0, 0, M, D, D, D, D, 1, 0, 0}; pg8::EpiRes E{XN, XN, XLO, nullptr, SS + (size_t)(l_ * 4 + 2) * M * 32, nullptr, nullptr, 1.0f, 0};
                    pg8::StaticOrder S; S.init(g.M, g.N, g.nS, gdim_, bid_, 1);
                    pg8::gemm_phase<pg8::EpiRes, pg8::StaticOrder>(c.lds, g, S, E);
                STEP_END
            } else {
                STEP_BEGIN
                    const bf16_t* PB = (const bf16_t*)(ws + WS_PB); const bf16_t* WPP = (const bf16_t*)(ws + WS_WPP); const bf16_t* WPG = (const bf16_t*)(ws + WS_WPG);
                    pg8::Gemm g{PB, WPP, (size_t)(XN - PB), (size_t)(WPG - WPP), M, D, D, D, D, 1, PLE, 0};
                    pg8::EpiRes E{XN, XNnext, XLO, (l_ + 1 < NL) ? nullptr : X, (l_ + 1 < NL) ? SS + (size_t)((l_ + 1) * 4) * M * 32 : nullptr, SS + (size_t)(l_ * 4 + 3) * M * 32, (const bf16_t*)(ws + WS_PP), 0.f, 1};
                    pg8::PleOrder S; S.so.init(g.M, g.N, 1, gdim_, bid_, 1);
                    pg8::gemm_phase<pg8::EpiRes, pg8::PleOrder>(c.lds, g, S, E);
                STEP_END
            }
        }
    }
#undef STEP_BEGIN
#undef STEP_END
}

#ifndef MK_PER_STEP
#define MK_PER_STEP 0
#endif
constexpr int NSTEPS_TOTAL = NL * (1 + 2 + 4 + 1 + 1 + 2 + 1);
extern "C" void kernel_launch(void* const* d_in, const int* in_sizes, int n_in, void* d_out, int out_size, void* d_ws, size_t ws_size, hipStream_t stream) {
    static int grid = 0;
    if (grid == 0) {
        if (n_in != 32 || out_size != M * D || ws_size < WS_END) { fprintf(stderr, "kernel_launch: unexpected shapes: n_in %d out %d ws %zu (need %zu)\n", n_in, out_size, ws_size, (size_t)WS_END); grid = -1; return; }
        int dev = 0, cus = 0, per_cu = 0;
        if (hipGetDevice(&dev) != hipSuccess || hipDeviceGetAttribute(&cus, hipDeviceAttributeMultiprocessorCount, dev) != hipSuccess) { grid = -1; return; }
        if (hipFuncSetAttribute((const void*)mk_fwd, hipFuncAttributeMaxDynamicSharedMemorySize, LDS_BYTES) != hipSuccess) { fprintf(stderr, "kernel_launch: hipFuncSetAttribute failed\n"); grid = -1; return; }
        if (hipOccupancyMaxActiveBlocksPerMultiprocessor(&per_cu, (const void*)mk_fwd, NTHR, LDS_BYTES) != hipSuccess || per_cu < 1) { fprintf(stderr, "kernel_launch: occupancy query says %d blocks per CU\n", per_cu); (void)hipGetLastError(); }
        grid = cus;
    }
    if (grid < 0) return;
    if (hipMemsetAsync((char*)d_ws + WS_CTL, 0, CTL_ZERO_BYTES, stream) != hipSuccess) return;
    Args a{};
    for (int i = 0; i < 32; ++i) a.in[i] = (const float*)d_in[i];
    a.out = (float*)d_out; a.ws = (unsigned char*)d_ws;
#if MK_PER_STEP
    for (int s = 0; s < NSTEPS_TOTAL; ++s) { a.s_lo = s; a.s_hi = s + 1; hipLaunchKernelGGL(mk_fwd, dim3(grid), dim3(NTHR), LDS_BYTES, stream, a); }
#else
    a.s_lo = 0; a.s_hi = NSTEPS_TOTAL;
    hipLaunchKernelGGL(mk_fwd, dim3(grid), dim3(NTHR), LDS_BYTES, stream, a);
#endif
}
```

```cpp
#include <hip/hip_runtime.h>
#include <cstdio>
#include <cstdint>

#define LAS __attribute__((address_space(3)))
#define GAS __attribute__((address_space(1)))
typedef unsigned short bf16_t;
typedef short bf16x8 __attribute__((ext_vector_type(8)));
typedef float f32x4 __attribute__((ext_vector_type(4)));
typedef float f32x2 __attribute__((ext_vector_type(2)));
typedef unsigned u32x4 __attribute__((ext_vector_type(4)));
typedef unsigned u32x2 __attribute__((ext_vector_type(2)));

constexpr int M = 16384, SEQ = 8192, D = 2048, F = 5504, NL = 4, PLE = 256, NIN = 18432;
constexpr int C_XA = 0, C_GA = 1024, C_XB = 2048, C_Q = 3072, C_K = 6144, C_V = 7168, C_ZU = 8192, C_ZV = 9216, C_GATE = 10240;
constexpr float EPS = 1e-6f;
constexpr int NWAVES = 8, NTHR = 512;

__device__ __forceinline__ unsigned f2bf(float f) { unsigned u = __builtin_bit_cast(unsigned, f); return (u + 0x7fffu + ((u >> 16) & 1u)) >> 16; }
__device__ __forceinline__ unsigned pk2(float lo, float hi) { return f2bf(lo) | (f2bf(hi) << 16); }
__device__ __forceinline__ float bf2f(unsigned short b) { return __builtin_bit_cast(float, ((unsigned)b) << 16); }
__device__ __forceinline__ float bflo(unsigned w) { return __builtin_bit_cast(float, w << 16); }
__device__ __forceinline__ float bfhi(unsigned w) { return __builtin_bit_cast(float, w & 0xffff0000u); }
__device__ __forceinline__ unsigned lo8_pack(float a, float b, float c, float d) {
    a = __builtin_amdgcn_fmed3f(a * 256.f, -224.f, 224.f); b = __builtin_amdgcn_fmed3f(b * 256.f, -224.f, 224.f); c = __builtin_amdgcn_fmed3f(c * 256.f, -224.f, 224.f); d = __builtin_amdgcn_fmed3f(d * 256.f, -224.f, 224.f);
    unsigned w = 0; w = __builtin_amdgcn_cvt_pk_fp8_f32(a, b, w, false); w = __builtin_amdgcn_cvt_pk_fp8_f32(c, d, w, true); return w;
}
__device__ __forceinline__ unsigned cvt_pk_bf16(float lo, float hi) { unsigned r; asm volatile("v_cvt_pk_bf16_f32 %0, %1, %2" : "=v"(r) : "v"(lo), "v"(hi)); return r; }
__device__ __forceinline__ float wave_sum(float v) {
#pragma unroll
    for (int o = 1; o < 64; o <<= 1) v += __shfl_xor(v, o);
    return v;
}
__device__ __forceinline__ float wave_max(float v) {
#pragma unroll
    for (int o = 1; o < 64; o <<= 1) v = fmaxf(v, __shfl_xor(v, o));
    return v;
}
__device__ __forceinline__ float sigmoidf_(float x) { return 1.0f / (1.0f + __expf(-x)); }
__device__ __forceinline__ float gelu_tanh(float x) {
    const float u = 0.7978845608028654f * (x + 0.044715f * x * x * x);
    const float t = 1.0f - 2.0f / (1.0f + __expf(2.0f * u));
    return 0.5f * x * (1.0f + t);
}
__device__ __forceinline__ float siluf_(float x) { return x / (1.0f + __expf(-x)); }

namespace pg8 {
constexpr int BM = 256, BK = 64, HALF = 128, HTB = HALF * BK * 2, STAGE_BYTES = 8 * HTB, NXCD = 8, WGM = 8;
__host__ __device__ __forceinline__ int lds_byte(int r, int c) { const int st = (r >> 4) * 2 + (c >> 5), rr = r & 15, cc = c & 31, ob = rr * 64 + cc * 2; return st * 1024 + (ob ^ (((ob >> 9) & 1) << 5)); }
__host__ __device__ __forceinline__ void stage_rc(int b, int& R, int& C) { const int st = b / 1024, sb = b % 1024, swz = sb ^ (((sb >> 9) & 1) << 5); R = (st >> 1) * 16 + swz / 64; C = (st & 1) * 32 + (swz % 64) / 2; }
__host__ __device__ __forceinline__ int perm32(int rho) { const int n = rho >> 4, i = rho & 15; return 8 * (i >> 2) + 4 * n + (i & 3); }

struct Unit { int pm, pn, sg; };
struct Gemm { const bf16_t* A; const bf16_t* Bt; size_t sgA, sgB; int M, N, K, lda, ldb, nS, K0, pad_; };

struct StaticOrder {
    int nM, nN, nS, nwg, G, c, alt;
    __device__ void init(int M_, int N_, int nS_, int G_, int c_, int alt_ = 0) { nM = M_ / BM; nN = N_ / BM; nS = nS_; nwg = nM * nN; G = G_; c = c_; alt = alt_; }
    __device__ bool next(int i, Unit& u) const {
        const int L = i * G + c; if (L >= nwg * nS) return false;
        if (nM == 64 && nS == 1) {
            const int xcd = L & 7, off = L >> 3; u.sg = 0;
            if (alt) { u.pm = 8 * xcd + (off & 3) + 4 * (off >> 5); u.pn = (off >> 2) & 7; }
            else { u.pm = 8 * xcd + (off & 7); u.pn = off >> 3; }
            return true;
        }
        int wgid = L % nwg; u.sg = L / nwg;
        { const int q = nwg / NXCD, r = nwg % NXCD, xcd = wgid % NXCD, off = wgid / NXCD; wgid = (xcd < r ? xcd * (q + 1) : r * (q + 1) + (xcd - r) * q) + off; }
        const int nig = WGM * nN, gid = wgid / nig, fm = gid * WGM, gsz = (nM - fm) < WGM ? (nM - fm) : WGM;
        u.pm = fm + ((wgid % nig) % gsz); u.pn = (wgid % nig) / gsz; return true;
    }
};

struct EpiPlain {
    static constexpr bool PERM = true, RSTD = false; const float* ss_in_unused() const { return nullptr; }
    bf16_t* O; int ldc, sgC;
    __device__ __forceinline__ bool keep(const Unit&) const { return false; }
    __device__ __forceinline__ void operator()(const f32x4 (&acc)[2][2][4][2], const Unit& u, int wr, int wc, int fr, int fq, const LAS float*) const {
        bf16_t* Ob = O + (size_t)(u.pm * BM + wr * 64 + fr) * ldc + u.pn * BM + wc * 32 + 8 * fq + u.sg * sgC;
#pragma unroll
        for (int ai = 0; ai < 2; ++ai)
#pragma unroll
            for (int m = 0; m < 4; ++m)
#pragma unroll
                for (int bj = 0; bj < 2; ++bj) { const f32x4 v0 = acc[ai][bj][m][0], v1 = acc[ai][bj][m][1];
                    u32x4 w; w.x = cvt_pk_bf16(v0[0], v0[1]); w.y = cvt_pk_bf16(v0[2], v0[3]); w.z = cvt_pk_bf16(v1[0], v1[1]); w.w = cvt_pk_bf16(v1[2], v1[3]);
                    *(u32x4*)(Ob + (size_t)(ai * HALF + m * 16) * ldc + bj * HALF) = w; }
    }
};

__device__ __forceinline__ float ld_agent(const float* p) { return __hip_atomic_load(p, __ATOMIC_RELAXED, __HIP_MEMORY_SCOPE_AGENT); }
__device__ __forceinline__ float rstd_of(const float* ssp, int row, int fq) {
    const f32x4 a = *(const f32x4*)(ssp + (size_t)row * 32 + 8 * fq), b = *(const f32x4*)(ssp + (size_t)row * 32 + 8 * fq + 4);
    float s = ((a[0] + a[1]) + (a[2] + a[3])) + ((b[0] + b[1]) + (b[2] + b[3]));
    s += __shfl_xor(s, 16); s += __shfl_xor(s, 32);
    return rsqrtf(s * (1.0f / 2048.0f) + 1e-6f);
}
__device__ __forceinline__ float gelu_f(float x) { const float u2 = x * (1.5957691216057308f + 0.07135481627f * x * x); return x - x * __builtin_amdgcn_rcpf(1.0f + __expf(u2)); }
__device__ __forceinline__ float sig_f(float x) { return __builtin_amdgcn_rcpf(1.0f + __expf(-x)); }

constexpr int RSTD_TAB = 135168;
__device__ __forceinline__ void fill_rstd(const float* ssp, int pm, LAS float* tab, int tid) {
    if (tid < 256) {
        const float* p = ssp + ((size_t)pm * 256 + tid) * 32; float s = 0.f;
#pragma unroll
        for (int i = 0; i < 8; ++i) { const f32x4 v = *(const f32x4*)(p + 4 * i); s += (v[0] + v[1]) + (v[2] + v[3]); }
        tab[tid] = rsqrtf(s * (1.0f / 2048.0f) + 1e-6f);
    }
    asm volatile("s_waitcnt lgkmcnt(0)" ::: "memory");
}
struct EpiUp {
    static constexpr bool PERM = true, RSTD = true;
    bf16_t* H; const float* ss_in;
    __device__ __forceinline__ void operator()(f32x4 (&acc)[2][2][4][2], const Unit& u, int wr, int wc, int fr, int fq, const LAS float* rtab) const {
        const int row0 = u.pm * BM + wr * 64 + fr, hcol0 = u.pn * 128 + wc * 32 + 8 * fq;
        float rsv[2][4];
#pragma unroll
        for (int ai = 0; ai < 2; ++ai)
#pragma unroll
            for (int m = 0; m < 4; ++m) rsv[ai][m] = rtab[wr * 64 + fr + ai * HALF + m * 16];
#pragma unroll
        for (int ai = 0; ai < 2; ++ai)
#pragma unroll
            for (int m = 0; m < 4; ++m) { const int row = row0 + ai * HALF + m * 16; const float rs = rsv[ai][m], rsl = rs * -1.4426950408889634f, rs2 = rs * rs;
                u32x4 w;
#pragma unroll
                for (int n = 0; n < 2; ++n) {
                    const f32x4 c1 = acc[ai][0][m][n], c3 = acc[ai][1][m][n]; const f32x4 t = c1 * rsl; f32x4 r;
#pragma unroll
                    for (int e = 0; e < 4; ++e) r[e] = __builtin_amdgcn_rcpf(1.0f + __builtin_amdgcn_exp2f(t[e]));
                    const f32x4 h = (c1 * c3) * (r * rs2);
                    w[2 * n] = cvt_pk_bf16(h[0], h[1]); w[2 * n + 1] = cvt_pk_bf16(h[2], h[3]); }
                *(u32x4*)(H + (size_t)row * 5504 + hcol0) = w; }
    }
    __device__ __forceinline__ bool keep(const Unit&) const { return false; }
};
struct EpiRes {
    static constexpr bool PERM = true, RSTD = true;
    const bf16_t* XHI_in; bf16_t* XHI_out; unsigned char* XLO; float* OUT32; float* ss_out; const float* ss_in; const bf16_t* PP; float alpha; int mode;
    __device__ __forceinline__ void operator()(f32x4 (&acc)[2][2][4][2], const Unit& u, int wr, int wc, int fr, int fq, const LAS float* rtab) const {
        const int row0 = u.pm * BM + wr * 64 + fr, col0 = u.pn * BM + wc * 32 + 8 * fq;
        if (mode && u.sg == 0) {
#pragma unroll
            for (int ai = 0; ai < 2; ++ai)
#pragma unroll
                for (int m = 0; m < 4; ++m)
#pragma unroll
                    for (int bj = 0; bj < 2; ++bj) { const f32x4 v0 = acc[ai][bj][m][0], v1 = acc[ai][bj][m][1];
                        u32x4 w; w[0] = cvt_pk_bf16(v0[0], v0[1]); w[1] = cvt_pk_bf16(v0[2], v0[3]); w[2] = cvt_pk_bf16(v1[0], v1[1]); w[3] = cvt_pk_bf16(v1[2], v1[3]);
                        *(u32x4*)(const_cast<bf16_t*>(PP) + (size_t)(row0 + ai * HALF + m * 16) * 2048 + col0 + bj * HALF) = w; }
            return;
        }
#pragma unroll
        for (int ai = 0; ai < 2; ++ai) {
            float rsv[4];
#pragma unroll
            for (int m = 0; m < 4; ++m) rsv[m] = mode ? rtab[wr * 64 + fr + ai * HALF + m * 16] : 0.f;
#pragma unroll
            for (int mp = 0; mp < 4; mp += 2) {
                u32x4 xh[2][2]; u32x2 xl[2][2]; u32x4 pq[2][2];
#pragma unroll
                for (int mm = 0; mm < 2; ++mm)
#pragma unroll
                    for (int bj = 0; bj < 2; ++bj) { const size_t o = (size_t)(row0 + ai * HALF + (mp + mm) * 16) * 2048 + col0 + bj * HALF;
                        xh[mm][bj] = *(const u32x4*)(XHI_in + o); xl[mm][bj] = *(const u32x2*)(XLO + o);
                        if (mode) pq[mm][bj] = *(const u32x4*)(PP + o); }
#pragma unroll
                for (int mm = 0; mm < 2; ++mm) { const int m = mp + mm; const int row = row0 + ai * HALF + m * 16; const float rs = rsv[m]; float part = 0.f;
#pragma unroll
                    for (int bj = 0; bj < 2; ++bj) { const size_t o = (size_t)row * 2048 + col0 + bj * HALF;
                        const u32x4 hh = xh[mm][bj]; const u32x2 ll = xl[mm][bj];
                        const f32x2 l01 = __builtin_amdgcn_cvt_pk_f32_fp8(ll.x, false), l23 = __builtin_amdgcn_cvt_pk_f32_fp8(ll.x, true), l45 = __builtin_amdgcn_cvt_pk_f32_fp8(ll.y, false), l67 = __builtin_amdgcn_cvt_pk_f32_fp8(ll.y, true);
                        constexpr float LS = 1.0f / 256.0f;
                        f32x4 x0 = (f32x4){bflo(hh[0]) + LS * l01[0], bfhi(hh[0]) + LS * l01[1], bflo(hh[1]) + LS * l23[0], bfhi(hh[1]) + LS * l23[1]};
                        f32x4 x1 = (f32x4){bflo(hh[2]) + LS * l45[0], bfhi(hh[2]) + LS * l45[1], bflo(hh[3]) + LS * l67[0], bfhi(hh[3]) + LS * l67[1]};
                        const f32x4 v0 = acc[ai][bj][m][0], v1 = acc[ai][bj][m][1];
                        if (mode) { const u32x4 pp = pq[mm][bj];
                            x0[0] += sig_f(rs * v0[0]) * bflo(pp[0]); x0[1] += sig_f(rs * v0[1]) * bfhi(pp[0]); x0[2] += sig_f(rs * v0[2]) * bflo(pp[1]); x0[3] += sig_f(rs * v0[3]) * bfhi(pp[1]);
                            x1[0] += sig_f(rs * v1[0]) * bflo(pp[2]); x1[1] += sig_f(rs * v1[1]) * bfhi(pp[2]); x1[2] += sig_f(rs * v1[2]) * bflo(pp[3]); x1[3] += sig_f(rs * v1[3]) * bfhi(pp[3]); }
                        else { x0 = x0 + alpha * v0; x1 = x1 + alpha * v1; }
                        u32x4 w; w[0] = cvt_pk_bf16(x0[0], x0[1]); w[1] = cvt_pk_bf16(x0[2], x0[3]); w[2] = cvt_pk_bf16(x1[0], x1[1]); w[3] = cvt_pk_bf16(x1[2], x1[3]);
                        *(u32x4*)(XHI_out + o) = w;
                        u32x2 wl; wl.x = lo8_pack(x0[0] - bflo(w[0]), x0[1] - bfhi(w[0]), x0[2] - bflo(w[1]), x0[3] - bfhi(w[1]));
                        wl.y = lo8_pack(x1[0] - bflo(w[2]), x1[1] - bfhi(w[2]), x1[2] - bflo(w[3]), x1[3] - bfhi(w[3]));
                        *(u32x2*)(XLO + o) = wl;
                        if (OUT32) { *(f32x4*)(OUT32 + o) = x0; *(f32x4*)(OUT32 + o + 4) = x1; }
                        part += (x0[0] * x0[0] + x0[1] * x0[1]) + (x0[2] * x0[2] + x0[3] * x0[3]) + (x1[0] * x1[0] + x1[1] * x1[1]) + (x1[2] * x1[2] + x1[3] * x1[3]); }
                    part += __shfl_xor(part, 16); part += __shfl_xor(part, 32);
                    if (ss_out && fq == 0) ss_out[(size_t)row * 32 + u.pn * 4 + wc] = part; }
                asm volatile("" ::: "memory");
            }
        }
    }
    __device__ __forceinline__ bool keep(const Unit&) const { return false; }
};
struct EpiIn {
    static constexpr bool PERM = true, RSTD = true;
    bf16_t* O; const float* ss_in; float* ssv; const float* bgate;
    __device__ __forceinline__ void operator()(f32x4 (&acc)[2][2][4][2], const Unit& u, int wr, int wc, int fr, int fq, const LAS float* rtab) const {
        const int row0 = u.pm * BM + wr * 64 + fr, col0 = u.pn * BM + wc * 32 + 8 * fq;
        const bool is_zv = (u.pn >= 36 && u.pn < 40);
        const bool do_gelu = (u.pn >= 4 && u.pn < 8) || (u.pn >= 32 && u.pn < 40);
        float rsv[2][4];
#pragma unroll
        for (int ai = 0; ai < 2; ++ai)
#pragma unroll
            for (int m = 0; m < 4; ++m) rsv[ai][m] = rtab[wr * 64 + fr + ai * HALF + m * 16];
        if (u.pn >= 40) {
            const int dbase = 64 * (u.pn - 40) + 16 * wc + 4 * fq;
            f32x4 bg[4];
#pragma unroll
            for (int b = 0; b < 4; ++b) bg[b] = *(const f32x4*)(bgate + b * 2048 + dbase);
#pragma unroll
            for (int ai = 0; ai < 2; ++ai)
#pragma unroll
                for (int m = 0; m < 4; ++m) { const int row = row0 + ai * HALF + m * 16; const float rs = rsv[ai][m];
                    f32x4 t[4], iv[4];
#pragma unroll
                    for (int b = 0; b < 4; ++b) { const f32x4 v = acc[ai][b >> 1][m][b & 1] * rs + bg[b];
#pragma unroll
                        for (int e = 0; e < 4; ++e) { const float x = fminf(fmaxf(v[e], -30.f), 30.f); t[b][e] = 1.0f + __expf(-x); iv[b][e] = __builtin_amdgcn_rcpf(t[b][e]); } }
                    bf16_t* op = O + (size_t)row * 18432 + 10240 + dbase;
#pragma unroll
                    for (int b = 0; b < 4; ++b) { const f32x4 r = (b < 3) ? t[b + 1] * iv[b] : iv[3];
                        u32x2 w; w.x = cvt_pk_bf16(r[0], r[1]); w.y = cvt_pk_bf16(r[2], r[3]); *(u32x2*)(op + b * 2048) = w; } }
            return;
        }
#pragma unroll
        for (int ai = 0; ai < 2; ++ai)
#pragma unroll
            for (int m = 0; m < 4; ++m) { const int row = row0 + ai * HALF + m * 16; const float rs = rsv[ai][m]; float part = 0.f;
#pragma unroll
                for (int bj = 0; bj < 2; ++bj) { f32x4 v0 = acc[ai][bj][m][0] * rs, v1 = acc[ai][bj][m][1] * rs;
                    if (do_gelu) {
#pragma unroll
                        for (int e = 0; e < 4; ++e) { v0[e] = gelu_f(v0[e]); v1[e] = gelu_f(v1[e]); } }
                    u32x4 w; w[0] = cvt_pk_bf16(v0[0], v0[1]); w[1] = cvt_pk_bf16(v0[2], v0[3]); w[2] = cvt_pk_bf16(v1[0], v1[1]); w[3] = cvt_pk_bf16(v1[2], v1[3]);
                    *(u32x4*)(O + (size_t)row * 18432 + col0 + bj * HALF) = w;
                    if (is_zv) part += (v0[0] * v0[0] + v0[1] * v0[1]) + (v0[2] * v0[2] + v0[3] * v0[3]) + (v1[0] * v1[0] + v1[1] * v1[1]) + (v1[2] * v1[2] + v1[3] * v1[3]); }
                if (is_zv) { part += __shfl_xor(part, 16); part += __shfl_xor(part, 32); if (fq == 0) ssv[(size_t)row * 16 + (u.pn - 36) * 4 + wc] = part; } }
    }
    __device__ __forceinline__ bool keep(const Unit&) const { return false; }
};

struct EpiBr {
    static constexpr bool PERM = true, RSTD = false;
    const bf16_t* R; bf16_t* O;
    __device__ __forceinline__ bool keep(const Unit& u) const { return u.sg != 3; }
    __device__ __forceinline__ void operator()(f32x4 (&acc)[2][2][4][2], const Unit& u, int wr, int wc, int fr, int fq, const LAS float* rtab) const {
        const int row0 = u.pm * BM + wr * 64 + fr, col0 = u.pn * BM + wc * 32 + 8 * fq;
#pragma unroll
        for (int ai = 0; ai < 2; ++ai) {
            u32x4 rr[4][2];
#pragma unroll
            for (int m = 0; m < 4; ++m)
#pragma unroll
                for (int bj = 0; bj < 2; ++bj) rr[m][bj] = *(const u32x4*)(R + (size_t)(row0 + ai * HALF + m * 16) * 18432 + u.sg * 2048 + col0 + bj * HALF);
#pragma unroll
            for (int m = 0; m < 4; ++m) { const int row = row0 + ai * HALF + m * 16;
#pragma unroll
                for (int bj = 0; bj < 2; ++bj) { const int col = col0 + bj * HALF;
                    const u32x4 r = rr[m][bj];
                    f32x4 v0 = acc[ai][bj][m][0], v1 = acc[ai][bj][m][1];
                    v0[0] *= bflo(r[0]); v0[1] *= bfhi(r[0]); v0[2] *= bflo(r[1]); v0[3] *= bfhi(r[1]);
                    v1[0] *= bflo(r[2]); v1[1] *= bfhi(r[2]); v1[2] *= bflo(r[3]); v1[3] *= bfhi(r[3]);
                    acc[ai][bj][m][0] = v0; acc[ai][bj][m][1] = v1;
                    if (u.sg == 3) { u32x4 w; w[0] = cvt_pk_bf16(v0[0], v0[1]); w[1] = cvt_pk_bf16(v0[2], v0[3]); w[2] = cvt_pk_bf16(v1[0], v1[1]); w[3] = cvt_pk_bf16(v1[2], v1[3]);
                        *(u32x4*)(O + (size_t)row * 2048 + col) = w; } } } }
    }
};
struct PleOrder {
    StaticOrder so;
    __device__ bool next(int i, Unit& u) const { Unit t; if (!so.next(i >> 1, t)) return false; u.pm = t.pm; u.pn = t.pn; u.sg = i & 1; return true; }
};
struct BrOrder {
    StaticOrder so;
    __device__ bool next(int i, Unit& u) const { Unit t; if (!so.next(i >> 2, t)) return false; u.pm = t.pm; u.pn = t.pn; u.sg = i & 3; return true; }
};

__device__ __forceinline__ const char* uni_ptr(const char* p) {
    const unsigned long long v = (unsigned long long)p; unsigned lo = __builtin_amdgcn_readfirstlane((unsigned)v), hi = __builtin_amdgcn_readfirstlane((unsigned)(v >> 32));
    asm volatile("" : "+s"(lo), "+s"(hi));
    return (const char*)(((unsigned long long)hi << 32) | lo);
}
__device__ __forceinline__ void glds16_s(const char* sbase, unsigned voff, unsigned lds_dst) {
    unsigned keep;
    asm volatile("s_mov_b32 %0, m0\n\ts_mov_b32 m0, %3\n\ts_nop 0\n\tglobal_load_lds_dwordx4 %1, %2\n\ts_mov_b32 m0, %0" : "=&s"(keep) : "v"(voff), "s"(sbase), "s"(lds_dst) : "memory");
}
template <class Epi, class Sched>
__device__ __forceinline__ void gemm_phase(LAS unsigned char* lds, const Gemm g, const Sched& S, const Epi& E) {
    int tid_ = threadIdx.x; asm volatile("" : "+v"(tid_));
    const int tid = tid_, wid = __builtin_amdgcn_readfirstlane(tid >> 6), lane = tid & 63, wr = wid >> 2, wc = wid & 3, fr = lane & 15, fq = lane >> 4;
    unsigned voffA[2], voffB[2];
#pragma unroll
    for (int i = 0; i < 2; ++i) { int R, C; stage_rc(tid * 16 + i * 8192, R, C); const int Rb = Epi::PERM ? ((R & ~31) + perm32(R & 31)) : R;
        voffA[i] = (unsigned)(R * g.lda + C) * 2u; voffB[i] = (unsigned)(Rb * g.ldb + C) * 2u; }
    constexpr unsigned kstep = BK * 2;
    const unsigned hstepA = (unsigned)HALF * g.lda * 2u, hstepB = (unsigned)HALF * g.ldb * 2u;
    const unsigned tstepA = 2u * hstepA, tstepB = 2u * hstepB;
    const unsigned ldsw = (unsigned)wid * 1024u;
    const unsigned ldsbase = (unsigned)(size_t)lds + ldsw;
    const int aoff = lds_byte(wr * 64 + fr, fq * 8), boff = lds_byte(wc * 32 + fr, fq * 8);
#define PG8_SA(b, h) (((b) * 2 + (h)) * HTB)
#define PG8_SB(b, h) ((4 + (b) * 2 + (h)) * HTB)
#define PG8_STAGE(bufoff, gbase, voff) do { const char* _gb = uni_ptr((const char*)(gbase)); _Pragma("unroll") for (int _i = 0; _i < 2; ++_i) \
        glds16_s(_gb, (voff)[_i], ldsbase + (unsigned)((bufoff) + _i * 8192)); } while (0)
#define PG8_LDA(dst, b, h) do { _Pragma("unroll") for (int m = 0; m < 4; ++m) _Pragma("unroll") for (int k = 0; k < 2; ++k) dst[m][k] = *(const LAS bf16x8*)(lds + PG8_SA(b, h) + aoff + m * 2048 + k * 1024); } while (0)
#define PG8_LDB(dst, b, h) do { _Pragma("unroll") for (int n = 0; n < 2; ++n) _Pragma("unroll") for (int k = 0; k < 2; ++k) dst[n][k] = *(const LAS bf16x8*)(lds + PG8_SB(b, h) + boff + n * 2048 + k * 1024); } while (0)
#define PG8_MMA(ai, bj, At, Bt) do { __builtin_amdgcn_s_setprio(1); _Pragma("unroll") for (int m = 0; m < 4; ++m) _Pragma("unroll") for (int n = 0; n < 2; ++n) _Pragma("unroll") for (int k = 0; k < 2; ++k) \
        acc[ai][bj][m][n] = __builtin_amdgcn_mfma_f32_16x16x32_bf16(Bt[n][k], At[m][k], acc[ai][bj][m][n], 0, 0, 0); __builtin_amdgcn_s_setprio(0); } while (0)
#define PG8_WAIT_V(n) asm volatile("s_waitcnt vmcnt(" #n ")" ::: "memory")
#define PG8_WAIT_L(n) asm volatile("s_waitcnt lgkmcnt(" #n ")" ::: "memory")
#define PG8_BAR __builtin_amdgcn_s_barrier()
#define PG8_SCHED __builtin_amdgcn_sched_barrier(0)
    Unit cur, nxt; int ui = 0;
    if (!S.next(0, cur)) return;
    LAS float* const rtab = (LAS float*)(lds + RSTD_TAB);
    int tab_pm = -1;
    if constexpr (Epi::RSTD) { if (E.ss_in) { fill_rstd(E.ss_in, cur.pm, rtab, tid); tab_pm = cur.pm; } }
    f32x4 acc[2][2][4][2];
#pragma unroll
    for (int a = 0; a < 2; ++a)
#pragma unroll
        for (int b = 0; b < 2; ++b)
#pragma unroll
            for (int m = 0; m < 4; ++m)
#pragma unroll
                for (int n = 0; n < 2; ++n) acc[a][b][m][n] = (f32x4){0.f, 0.f, 0.f, 0.f};
    bf16x8 At[4][2], B0[2][2], B1[2][2];
    const char* cA = (const char*)(g.A + (size_t)cur.sg * g.sgA) + (size_t)((unsigned)cur.pm * tstepA); const char* cB = (const char*)(g.Bt + (size_t)cur.sg * g.sgB) + (size_t)((unsigned)cur.pn * tstepB);
    PG8_STAGE(PG8_SB(0, 0), cB, voffB); PG8_STAGE(PG8_SB(0, 1), cB + hstepB, voffB); PG8_STAGE(PG8_SA(0, 0), cA, voffA); PG8_STAGE(PG8_SA(0, 1), cA + hstepA, voffA);
    if (wr == 1) PG8_BAR;
    PG8_WAIT_V(2); PG8_BAR;
    PG8_STAGE(PG8_SB(1, 0), cB + kstep, voffB); PG8_STAGE(PG8_SA(1, 0), cA + kstep, voffA); PG8_STAGE(PG8_SB(1, 1), cB + hstepB + kstep, voffB);
    PG8_WAIT_V(6); PG8_BAR;
    for (;;) {
        const int nt = ((g.K0 != 0 && cur.sg == 0) ? g.K0 : g.K) / BK;
        const bool has_next = S.next(ui + 1, nxt);
        const char* nA = has_next ? (const char*)(g.A + (size_t)nxt.sg * g.sgA) + (size_t)((unsigned)nxt.pm * tstepA) : cA;
        const char* nB = has_next ? (const char*)(g.Bt + (size_t)nxt.sg * g.sgB) + (size_t)((unsigned)nxt.pn * tstepB) : cB;
        for (int t = 0; t < nt; t += 2) {
            const bool last = (t == nt - 2);
            const char* a1 = cA + (unsigned)(t + 1) * kstep;
            const char* a2 = last ? nA : cA + (unsigned)(t + 2) * kstep; const char* b2 = last ? nB : cB + (unsigned)(t + 2) * kstep;
            const char* a3 = a2 + kstep; const char* b3 = b2 + kstep;
            PG8_LDB(B0, 0, 0); PG8_LDB(B1, 0, 1); PG8_SCHED; PG8_LDA(At, 0, 0); PG8_STAGE(PG8_SA(1, 1), a1 + hstepA, voffA);
            PG8_WAIT_V(8); PG8_WAIT_L(0); PG8_BAR; PG8_MMA(0, 0, At, B0); PG8_MMA(0, 1, At, B1); PG8_BAR; PG8_SCHED;
            PG8_LDA(At, 0, 1); PG8_STAGE(PG8_SB(0, 0), b2, voffB); PG8_STAGE(PG8_SB(0, 1), b2 + hstepB, voffB); PG8_STAGE(PG8_SA(0, 0), a2, voffA);
            PG8_WAIT_V(8); PG8_WAIT_L(0); PG8_BAR; PG8_MMA(1, 0, At, B0); PG8_MMA(1, 1, At, B1); PG8_BAR; PG8_SCHED;
            PG8_LDB(B0, 1, 0); PG8_LDB(B1, 1, 1); PG8_SCHED; PG8_LDA(At, 1, 0); PG8_STAGE(PG8_SA(0, 1), a2 + hstepA, voffA);
            PG8_WAIT_V(8); PG8_WAIT_L(0); PG8_BAR; PG8_MMA(0, 0, At, B0); PG8_MMA(0, 1, At, B1); PG8_BAR; PG8_SCHED;
            PG8_LDA(At, 1, 1); PG8_STAGE(PG8_SB(1, 0), b3, voffB); PG8_STAGE(PG8_SB(1, 1), b3 + hstepB, voffB); PG8_STAGE(PG8_SA(1, 0), a3, voffA);
            PG8_WAIT_V(8); PG8_WAIT_L(0); PG8_BAR; PG8_MMA(1, 0, At, B0); PG8_MMA(1, 1, At, B1); PG8_BAR; PG8_SCHED;
        }
        if (wr == 0) PG8_BAR;
        if constexpr (Epi::RSTD) { if (E.ss_in && cur.pm != tab_pm) { fill_rstd(E.ss_in, cur.pm, rtab, tid); PG8_BAR; tab_pm = cur.pm; } }
        E(acc, cur, wr, wc, fr, fq, rtab);
        if (!has_next) break;
        if (!E.keep(cur)) {
#pragma unroll
        for (int a = 0; a < 2; ++a)
#pragma unroll
            for (int b = 0; b < 2; ++b)
#pragma unroll
                for (int m = 0; m < 4; ++m)
#pragma unroll
                    for (int n = 0; n < 2; ++n) acc[a][b][m][n] = (f32x4){0.f, 0.f, 0.f, 0.f};
        }
        cur = nxt; cA = nA; cB = nB; ++ui;
        if (wr == 1) PG8_BAR;
    }
    PG8_WAIT_V(0);
    PG8_BAR;
#undef PG8_SA
#undef PG8_SB
#undef PG8_STAGE
#undef PG8_LDA
#undef PG8_LDB
#undef PG8_MMA
#undef PG8_WAIT_V
#undef PG8_WAIT_L
#undef PG8_BAR
#undef PG8_SCHED
}
}

constexpr size_t MiB = 1u << 20;
constexpr size_t al(size_t x) { return (x + 4095) & ~(size_t)4095; }
constexpr size_t SZ_W13 = (size_t)2 * F * D * 2, SZ_W2 = (size_t)D * F * 2, SZ_WIN = (size_t)NIN * D * 2, SZ_WBR = (size_t)4 * D * 1024 * 2, SZ_WOUT = (size_t)D * D * 2,
                 SZ_WPG = (size_t)D * D * 2, SZ_WPP = (size_t)D * 2048 * 2  , SZ_WPOOL = (size_t)4 * 256 * 256 * 2;
constexpr size_t WS_CTL = 0;
constexpr size_t WS_W13A = 1 * MiB;
constexpr size_t WS_W2A = WS_W13A + al(SZ_W13);
constexpr size_t WS_WIN = WS_W2A + al(SZ_W2);
constexpr size_t WS_WBR = WS_WIN + al(SZ_WIN);
constexpr size_t WS_WOUT = WS_WBR + al(SZ_WBR);
constexpr size_t WS_W13B = WS_WOUT + al(SZ_WOUT);
constexpr size_t WS_W2B = WS_W13B + al(SZ_W13);
constexpr size_t WS_WPG = WS_W2B + al(SZ_W2);
constexpr size_t WS_WPP = WS_WPG + al(SZ_WPG);
constexpr size_t WS_WPOOL = WS_WPP + al(SZ_WPP);
constexpr size_t WS_WGT = WS_WPOOL + al(SZ_WPOOL);
constexpr size_t WS_WSB = WS_WGT + al((size_t)2 * 16 * 64 * 64 * 2);
constexpr size_t WS_PB = WS_WSB + al((size_t)8 * 128 * 128 * 2);
constexpr size_t WS_XN = WS_PB + al((size_t)M * 2048 * 2);
constexpr size_t WS_XN2 = WS_XN + al((size_t)M * D * 2);
constexpr size_t WS_XLO = WS_XN2 + al((size_t)M * D * 2);
constexpr size_t WS_PROJ = WS_XLO + al((size_t)M * D * 2);
constexpr size_t WS_H = WS_PROJ;
constexpr size_t WS_PL = WS_PROJ + al((size_t)M * NIN * 2);
constexpr size_t WS_Y = WS_PL + al((size_t)M * 1024 * 2);
constexpr size_t WS_MRGB = WS_Y + al((size_t)4 * M * 1024 * 2);
constexpr size_t WS_OG = WS_MRGB + al((size_t)M * D * 2);
constexpr size_t WS_LSE = WS_OG + al((size_t)3 * M * 1024 * 2);
constexpr size_t WS_SS = WS_LSE + al((size_t)3 * M * 8 * 4);
constexpr size_t WS_PP = WS_SS + al((size_t)(NL * 4 + 1) * M * 32 * 4);
constexpr size_t WS_HL = WS_PP + al((size_t)M * D * 2);
constexpr size_t WS_AC = WS_HL + al((size_t)M * 1024 * 2);
constexpr size_t WS_CSA = WS_AC + al((size_t)M * 1024 * 2);
constexpr size_t WS_CSH = WS_CSA + al((size_t)128 * 1024 * 4);
constexpr size_t WS_SSV = WS_CSH + al((size_t)128 * 1024 * 4);
constexpr size_t WS_CIN = WS_SSV + al((size_t)M * 16 * 4);
constexpr size_t WS_END = WS_CIN + al((size_t)128 * 1024 * 4);
static_assert((size_t)M * F * 2 <= (size_t)M * NIN * 2, "H overlay fits inside PROJ");

struct Args { const float* in[32]; float* out; unsigned char* ws; int s_lo, s_hi; };
typedef const Args __attribute__((address_space(4)))* ArgsP;

struct Ctx { int tid, lane, wave, gw, NGW, gtid, NGT, bid, gdim; LAS unsigned char* lds; };

__device__ __forceinline__ void tr_item(const float* W, int ldw, int k0, int n0, bf16_t* WT, int ldt, int drow0, const float* ksc, const float* nsc, LAS float* scr, int lane) {
    {
        const int c4 = (lane & 7) * 4; f32x4 v[8];
#pragma unroll
        for (int i = 0; i < 8; ++i) v[i] = *(const f32x4*)(W + (size_t)(k0 + 8 * i + (lane >> 3)) * ldw + n0 + c4);
        f32x4 ns = (f32x4){1.f, 1.f, 1.f, 1.f}; if (nsc) ns = *(const f32x4*)(nsc + n0 + c4);
#pragma unroll
        for (int i = 0; i < 8; ++i) { const int kk = 8 * i + (lane >> 3); f32x4 x = v[i] * ns; if (ksc) x = x * ksc[k0 + kk];
            scr[kk * 33 + c4] = x[0]; scr[kk * 33 + c4 + 1] = x[1]; scr[kk * 33 + c4 + 2] = x[2]; scr[kk * 33 + c4 + 3] = x[3]; }
    }
    asm volatile("s_waitcnt lgkmcnt(0)" ::: "memory");
    const int c = lane & 7;
#pragma unroll
    for (int j = 0; j < 4; ++j) { const int n = (lane >> 3) + 8 * j; const LAS float* s = scr + (8 * c) * 33 + n;
        u32x4 o; o.x = pk2(s[0 * 33], s[1 * 33]); o.y = pk2(s[2 * 33], s[3 * 33]); o.z = pk2(s[4 * 33], s[5 * 33]); o.w = pk2(s[6 * 33], s[7 * 33]);
        int dr = drow0 + n;
        if (drow0 < 0) {
            const int gcol = n0 + n - C_GATE, b = gcol >> 11, d = gcol & 2047, dl = d & 63;
            dr = C_GATE + 256 * (d >> 6) + 128 * (b >> 1) + 32 * (dl >> 4) + 8 * ((dl >> 2) & 3) + 4 * (b & 1) + (dl & 3);
        }
        *(u32x4*)(WT + (size_t)dr * ldt + k0 + 8 * c) = o; }
    asm volatile("s_waitcnt lgkmcnt(0)" ::: "memory");
}
__device__ __forceinline__ void tr_matrix(const Ctx& c, int& base, const float* W, int K, int N, bf16_t* WT, const float* ksc, int mode  , const float* nsc = nullptr, int ldt = 0) {
    LAS float* scr = (LAS float*)(c.lds + c.wave * 16384);
    const int nblk = N / 32, nitems = (K / 64) * nblk;
    int first = (c.gw - base) % c.NGW; if (first < 0) first += c.NGW;
    base = (base + nitems) % c.NGW;
    for (int it = first; it < nitems; it += c.NGW) {
        const int kb = it / nblk, nb = it % nblk, k0 = 64 * kb, n0 = 32 * nb;
        int drow0 = n0;
        if (mode == 1 || mode == 2) drow0 = (n0 / 128) * 256 + (n0 % 128) + (mode == 2 ? 128 : 0);
        if (mode == 3 && n0 >= C_GATE) drow0 = -1;
        tr_item(W, N, k0, n0, WT, ldt ? ldt : K, drow0, ksc, nsc, scr, c.lane);
    }
}

__device__ __forceinline__ void phase_prep(const Ctx& c, ArgsP a, int l) {
    unsigned char* ws = a->ws; int base = 0;
    tr_matrix(c, base, a->in[3] + (size_t)l * D * F, D, F, (bf16_t*)(ws + WS_W13A), a->in[2] + (size_t)l * D, 1);
    tr_matrix(c, base, a->in[4] + (size_t)l * D * F, D, F, (bf16_t*)(ws + WS_W13A), a->in[2] + (size_t)l * D, 2);
    tr_matrix(c, base, a->in[5] + (size_t)l * F * D, F, D, (bf16_t*)(ws + WS_W2A), nullptr, 0);
    tr_matrix(c, base, a->in[7] + (size_t)l * D * NIN, D, NIN, (bf16_t*)(ws + WS_WIN), a->in[6] + (size_t)l * D, 3);
    for (int b = 0; b < 4; ++b) tr_matrix(c, base, a->in[23] + ((size_t)l * 4 + b) * 1024 * D, 1024, D, (bf16_t*)(ws + WS_WBR) + (size_t)b * D * 1024, nullptr, 0);
    tr_matrix(c, base, a->in[24] + (size_t)l * D * D, D, D, (bf16_t*)(ws + WS_WOUT), nullptr, 0);
    tr_matrix(c, base, a->in[26] + (size_t)l * D * F, D, F, (bf16_t*)(ws + WS_W13B), a->in[25] + (size_t)l * D, 1);
    tr_matrix(c, base, a->in[27] + (size_t)l * D * F, D, F, (bf16_t*)(ws + WS_W13B), a->in[25] + (size_t)l * D, 2);
    tr_matrix(c, base, a->in[28] + (size_t)l * F * D, F, D, (bf16_t*)(ws + WS_W2B), nullptr, 0);
    tr_matrix(c, base, a->in[30] + (size_t)l * D * D, D, D, (bf16_t*)(ws + WS_WPG), a->in[29] + (size_t)l * D, 0);
    tr_matrix(c, base, a->in[31] + (size_t)l * PLE * D, PLE, D, (bf16_t*)(ws + WS_WPP), nullptr, 0, nullptr, 2048);
    for (int g = 0; g < 4; ++g) tr_matrix(c, base, a->in[16] + ((size_t)l * 4 + g) * 256 * 256, 256, 256, (bf16_t*)(ws + WS_WPOOL) + (size_t)g * 256 * 256, nullptr, 0, a->in[17] + (size_t)l * 1024 + g * 256);
    for (int hh = 0; hh < 16; ++hh) {
        tr_matrix(c, base, a->in[11] + ((size_t)l * 16 + hh) * 4096, 64, 64, (bf16_t*)(ws + WS_WGT) + (size_t)hh * 4096, nullptr, 0);
        tr_matrix(c, base, a->in[13] + ((size_t)l * 16 + hh) * 4096, 64, 64, (bf16_t*)(ws + WS_WGT) + (size_t)(16 + hh) * 4096, nullptr, 0);
    }
    {
        const float* sw = a->in[21] + (size_t)l * 8 * 128 * 128; bf16_t* wsb = (bf16_t*)(ws + WS_WSB);
        for (int i = c.gtid; i < 8 * 128 * 128; i += c.NGT) { const int t = (i >> 7) & 127, s = i & 127; wsb[i] = (s <= t) ? (bf16_t)f2bf(sw[i]) : (bf16_t)0; }
    }
    {
        const float* p = a->in[1] + (size_t)l * M * PLE; bf16_t* pb = (bf16_t*)(ws + WS_PB);
        for (int i = c.gtid; i < M * PLE / 4; i += c.NGT) { const f32x4 v = *(const f32x4*)(p + 4 * (size_t)i); const int m = i >> 6, cc = (i & 63) * 4;
            u32x2 w; w.x = pk2(v[0], v[1]); w.y = pk2(v[2], v[3]); *(u32x2*)(pb + (size_t)m * 2048 + cc) = w; }
    }
}

__device__ __forceinline__ void phase_init(const Ctx& c, ArgsP a) {
    const float* xin = a->in[0]; bf16_t* XB = (bf16_t*)(a->ws + WS_XN); unsigned char* XL = a->ws + WS_XLO; float* SS = (float*)(a->ws + WS_SS);
    for (int m = c.gw; m < M; m += c.NGW) {
        float ss = 0.f;
#pragma unroll
        for (int j = 0; j < 8; ++j) { const size_t o = (size_t)m * D + 256 * j + 4 * c.lane; const f32x4 x = *(const f32x4*)(xin + o);
            u32x2 w; w.x = pk2(x[0], x[1]); w.y = pk2(x[2], x[3]); *(u32x2*)(XB + o) = w;
            *(unsigned*)(XL + o) = lo8_pack(x[0] - bflo(w.x), x[1] - bfhi(w.x), x[2] - bflo(w.y), x[3] - bfhi(w.y));
            ss += (x[0] * x[0] + x[1] * x[1]) + (x[2] * x[2] + x[3] * x[3]); }
        ss = wave_sum(ss);
        if (c.lane < 32) SS[(size_t)m * 32 + c.lane] = (c.lane == 0) ? ss : 0.f;
    }
}

typedef short s16x4 __attribute__((ext_vector_type(4)));
constexpr int ATT_K_OFF = 0, ATT_V_OFF = 65536, ATT_RK_OFF = 132096;
struct AttItem { int b, h, g, r, nb, dsh, rowb; };
__device__ __forceinline__ AttItem att_decode(int it) {
    AttItem t; t.h = it & 7; const int rest = it >> 3, q48 = rest % 192, span = q48 / 48, jj = q48 % 48, e16 = jj & 15;
    t.b = rest / 192; t.g = jj >> 4; t.dsh = 2 * t.g; t.rowb = t.b * SEQ;
    t.r = (t.g == 0) ? 0 : (t.g == 1 ? (e16 & 3) : e16); t.nb = (t.g == 0) ? span * 16 + e16 : (t.g == 1 ? span * 4 + (e16 >> 2) : span);
    return t;
}
template <int VT> __device__ __forceinline__ void att_dma(const bf16_t* P, const AttItem& t, LAS unsigned char* lds, int w, int lane) {
#pragma unroll
    for (int i = 0; i < 8; ++i) {
        const int q = w * 8 + i, trow = 4 * q + (lane >> 4), pc = lane & 15;
        int pos = ((128 * (t.nb - 1) + trow) << t.dsh) + t.r; if (pos < 0) pos = t.r;
        const bf16_t* src = P + (size_t)(t.rowb + pos) * NIN + t.h * 128;
        if (VT == 0) __builtin_amdgcn_global_load_lds((const unsigned*)(src + C_K + ((pc ^ (trow & 15)) << 3)), (LAS unsigned*)(lds + ATT_K_OFF + q * 1024), 16, 0, 0);
        else         __builtin_amdgcn_global_load_lds((const unsigned*)(src + C_V + ((pc ^ ((trow & 7) << 1)) << 3)), (LAS unsigned*)(lds + ATT_V_OFF + q * 1024), 16, 0, 0);
    }
}
constexpr int ATT_GT_OFF = 133120;
__device__ __forceinline__ void att_qprep(const u32x4 (&qraw)[4], LAS unsigned char* lds, int kq, bf16x8 (&qf)[4], float& rq) {
    float ssq = 0.f;
#pragma unroll
    for (int ks = 0; ks < 4; ++ks) {
        const u32x4 qr = qraw[ks];
        const f32x4 ga = *(const LAS f32x4*)(lds + ATT_GT_OFF + (32 * ks + 8 * kq) * 4), gb = *(const LAS f32x4*)(lds + ATT_GT_OFF + (32 * ks + 8 * kq + 4) * 4);
        u32x4 o; float lo, hi;
        lo = bflo(qr[0]); hi = bfhi(qr[0]); ssq += lo * lo + hi * hi; o[0] = pk2(lo * ga[0], hi * ga[1]);
        lo = bflo(qr[1]); hi = bfhi(qr[1]); ssq += lo * lo + hi * hi; o[1] = pk2(lo * ga[2], hi * ga[3]);
        lo = bflo(qr[2]); hi = bfhi(qr[2]); ssq += lo * lo + hi * hi; o[2] = pk2(lo * gb[0], hi * gb[1]);
        lo = bflo(qr[3]); hi = bfhi(qr[3]); ssq += lo * lo + hi * hi; o[3] = pk2(lo * gb[2], hi * gb[3]);
        qf[ks] = __builtin_bit_cast(bf16x8, o);
    }
    ssq += __shfl_xor(ssq, 16); ssq += __shfl_xor(ssq, 32);
    rq = rsqrtf(ssq * (1.0f / 128.0f) + EPS);
}
#define ATT_BAR() do { asm volatile("s_waitcnt lgkmcnt(0)" ::: "memory"); __builtin_amdgcn_s_barrier(); asm volatile("" ::: "memory"); } while (0)
__device__ __forceinline__ void phase_attn(const Ctx& c, ArgsP a, int l) {
    const bf16_t* P = (const bf16_t*)(a->ws + WS_PROJ); bf16_t* OG = (bf16_t*)(a->ws + WS_OG); float* LSE = (float*)(a->ws + WS_LSE);
    const float* qg = a->in[18] + (size_t)l * 128; const float* kg = a->in[19] + (size_t)l * 128;
    const int w = c.wave, lane = c.lane, n = lane & 15, kq = lane >> 4;
    LAS unsigned char* lds = c.lds;
    int it = c.bid; if (it >= 3072) return;
    if (c.tid < 128) *(LAS float*)(lds + ATT_GT_OFF + c.tid * 4) = qg[c.tid] * kg[c.tid] * 0.08838834764831845f;
    ATT_BAR();
    AttItem cur = att_decode(it);
    u32x4 qraw[4]; bf16x8 qf[4]; float rq;
    att_dma<0>(P, cur, lds, w, lane);
    { const size_t qrow0 = (size_t)cur.rowb + (((128 * cur.nb + 16 * w + n) << cur.dsh) + cur.r);
#pragma unroll
      for (int ks = 0; ks < 4; ++ks) qraw[ks] = *(const u32x4*)(P + qrow0 * NIN + C_Q + (cur.g * 8 + cur.h) * 128 + 32 * ks + 8 * kq); }
    asm volatile("s_waitcnt vmcnt(0)" ::: "memory");
    att_qprep(qraw, lds, kq, qf, rq);
    att_dma<1>(P, cur, lds, w, lane);
    for (;;) {
        const int itn = it + c.gdim; const bool has_next = itn < 3072; const AttItem nxt = att_decode(has_next ? itn : it);
        const int h = cur.h, g = cur.g, nb = cur.nb;
        const size_t qrow = (size_t)cur.rowb + (((128 * nb + 16 * w + n) << cur.dsh) + cur.r);
        ATT_BAR();
        {
            const int krow = c.tid >> 1, hf = c.tid & 1; float s = 0.f;
#pragma unroll
            for (int cc = 0; cc < 8; ++cc) { const u32x4 kv = *(const LAS u32x4*)(lds + ATT_K_OFF + krow * 256 + ((hf * 8 + cc) << 4));
#pragma unroll
                for (int e = 0; e < 4; ++e) { const float lo = bflo(kv[e]), hi = bfhi(kv[e]); s += lo * lo + hi * hi; } }
            s += __shfl_xor(s, 1);
            if (hf == 0) *(LAS float*)(lds + ATT_RK_OFF + krow * 4) = rsqrtf(s * (1.0f / 128.0f) + EPS);
        }
        f32x4 st[9];
#pragma unroll
        for (int T = 0; T < 9; ++T) {
            f32x4 acc = (f32x4){0.f, 0.f, 0.f, 0.f};
#pragma unroll
            for (int ks = 0; ks < 4; ++ks) {
                const bf16x8 kf = *(const LAS bf16x8*)(lds + ATT_K_OFF + (16 * (w + T) + n) * 256 + (((4 * ks + kq) ^ n) << 4));
                acc = __builtin_amdgcn_mfma_f32_16x16x32_bf16(kf, qf[ks], acc, 0, 0, 0);
            }
            st[T] = acc;
        }
        ATT_BAR();
        if (has_next) {
            const size_t qrown = (size_t)nxt.rowb + (((128 * nxt.nb + 16 * w + n) << nxt.dsh) + nxt.r);
#pragma unroll
            for (int ks = 0; ks < 4; ++ks) qraw[ks] = *(const u32x4*)(P + qrown * NIN + C_Q + (nxt.g * 8 + nxt.h) * 128 + 32 * ks + 8 * kq);
            att_dma<0>(P, nxt, lds, w, lane);
        }
        float mx = -1e30f;
#pragma unroll
        for (int T = 0; T < 9; ++T) {
            const f32x4 rk4 = *(const LAS f32x4*)(lds + ATT_RK_OFF + (16 * (w + T) + 4 * kq) * 4);
#pragma unroll
            for (int e = 0; e < 4; ++e) {
                const int kl = 16 * T + 4 * kq + e;
                const bool valid = (kl >= n) && (kl <= n + 128) && (nb > 0 || 16 * w + kl >= 128);
                const float s = valid ? st[T][e] * rk4[e] * rq : -1e30f;
                st[T][e] = s; mx = fmaxf(mx, s);
            }
        }
        mx = fmaxf(mx, __shfl_xor(mx, 16)); mx = fmaxf(mx, __shfl_xor(mx, 32));
        float sum = 0.f;
#pragma unroll
        for (int T = 0; T < 9; ++T)
#pragma unroll
            for (int e = 0; e < 4; ++e) { const float p = (st[T][e] > -1e29f) ? __expf(st[T][e] - mx) : 0.f; st[T][e] = p; sum += p; }
        sum += __shfl_xor(sum, 16); sum += __shfl_xor(sum, 32);
        if (has_next) asm volatile("s_waitcnt vmcnt(8)" ::: "memory"); else asm volatile("s_waitcnt vmcnt(0)" ::: "memory");
        ATT_BAR();
        f32x4 oacc[8];
#pragma unroll
        for (int dt = 0; dt < 8; ++dt) oacc[dt] = (f32x4){0.f, 0.f, 0.f, 0.f};
#pragma unroll
        for (int p = 0; p < 5; ++p) {
            const int T0 = 2 * p, T1 = (2 * p + 1 <= 8) ? 2 * p + 1 : 8;
            u32x4 pw; pw[0] = pk2(st[T0][0], st[T0][1]); pw[1] = pk2(st[T0][2], st[T0][3]);
            if (2 * p + 1 <= 8) { pw[2] = pk2(st[T1][0], st[T1][1]); pw[3] = pk2(st[T1][2], st[T1][3]); } else { pw[2] = 0u; pw[3] = 0u; }
            const bf16x8 pf = __builtin_bit_cast(bf16x8, pw);
            const int vr0 = 16 * (w + T0) + 4 * kq + (n >> 2), vr1 = 16 * (w + T1) + 4 * kq + (n >> 2);
#pragma unroll
            for (int dt = 0; dt < 8; ++dt) {
                const int ch = 2 * dt + ((lane & 3) >> 1);
                const s16x4 v0 = __builtin_amdgcn_ds_read_tr16_b64_v4i16((LAS s16x4*)(lds + ATT_V_OFF + vr0 * 256 + ((ch ^ ((vr0 & 7) << 1)) << 4) + (lane & 1) * 8));
                const s16x4 v1 = __builtin_amdgcn_ds_read_tr16_b64_v4i16((LAS s16x4*)(lds + ATT_V_OFF + vr1 * 256 + ((ch ^ ((vr1 & 7) << 1)) << 4) + (lane & 1) * 8));
                const bf16x8 vf = (bf16x8){v0[0], v0[1], v0[2], v0[3], v1[0], v1[1], v1[2], v1[3]};
                oacc[dt] = __builtin_amdgcn_mfma_f32_16x16x32_bf16(vf, pf, oacc[dt], 0, 0, 0);
            }
        }
        ATT_BAR();
        asm volatile("s_waitcnt vmcnt(0)" ::: "memory");
        const float inv = 1.0f / sum; const float lse = mx + __logf(sum);
        if (has_next) att_qprep(qraw, lds, kq, qf, rq);
        bf16_t* op = OG + ((size_t)g * M + qrow) * 1024 + h * 128 + 4 * kq;
#pragma unroll
        for (int dt = 0; dt < 8; ++dt) { u32x2 o; o.x = pk2(oacc[dt][0] * inv, oacc[dt][1] * inv); o.y = pk2(oacc[dt][2] * inv, oacc[dt][3] * inv); *(u32x2*)(op + 16 * dt) = o; }
        if (kq == 0) LSE[((size_t)g * M + qrow) * 8 + h] = lse;
        if (!has_next) break;
        att_dma<1>(P, nxt, lds, w, lane);
        cur = nxt; it = itn;
    }
}
#undef ATT_BAR
__device__ __forceinline__ void phase_attn_merge(const Ctx& c, ArgsP a) {
    const bf16_t* OG = (const bf16_t*)(a->ws + WS_OG); const float* LSE = (const float*)(a->ws + WS_LSE); bf16_t* Y2 = (bf16_t*)(a->ws + WS_Y) + (size_t)2 * M * 1024;
    for (size_t i0 = c.gtid; i0 < (size_t)M * 128; i0 += (size_t)4 * c.NGT) {
        float l0[4], l1[4], l2[4]; u32x4 a0[4], a1[4], a2[4];
#pragma unroll
        for (int k = 0; k < 4; ++k) { const size_t i = i0 + (size_t)k * c.NGT; const size_t m = i >> 7; const int c8 = (int)(i & 127) * 8, h = c8 >> 7;
            l0[k] = LSE[m * 8 + h]; l1[k] = LSE[((size_t)M + m) * 8 + h]; l2[k] = LSE[((size_t)2 * M + m) * 8 + h];
            a0[k] = *(const u32x4*)(OG + m * 1024 + c8); a1[k] = *(const u32x4*)(OG + ((size_t)M + m) * 1024 + c8); a2[k] = *(const u32x4*)(OG + ((size_t)2 * M + m) * 1024 + c8); }
#pragma unroll
        for (int k = 0; k < 4; ++k) { const size_t i = i0 + (size_t)k * c.NGT; const size_t m = i >> 7; const int c8 = (int)(i & 127) * 8;
            const float mm = fmaxf(l0[k], fmaxf(l1[k], l2[k])); float e0 = __expf(l0[k] - mm), e1 = __expf(l1[k] - mm), e2 = __expf(l2[k] - mm); const float inv = 1.0f / (e0 + e1 + e2); e0 *= inv; e1 *= inv; e2 *= inv;
            u32x4 o;
#pragma unroll
            for (int e = 0; e < 4; ++e) o[e] = pk2(e0 * bflo(a0[k][e]) + e1 * bflo(a1[k][e]) + e2 * bflo(a2[k][e]), e0 * bfhi(a0[k][e]) + e1 * bfhi(a1[k][e]) + e2 * bfhi(a2[k][e]));
            *(u32x4*)(Y2 + m * 1024 + c8) = o; }
    }
}

constexpr int A1_XC32 = 0, A1_XCB = 32768, A1_A32 = 49152, A1_U32 = 83968, A1_SUM = 118784;
#define A1_BAR() do { asm volatile("s_waitcnt lgkmcnt(0)" ::: "memory"); __builtin_amdgcn_s_barrier(); asm volatile("" ::: "memory"); } while (0)
#define A1_WSYNC() asm volatile("s_waitcnt lgkmcnt(0)" ::: "memory")
__device__ __forceinline__ void phase_a1(const Ctx& c, ArgsP a, int l) {
    const bf16_t* P = (const bf16_t*)(a->ws + WS_PROJ); const bf16_t* WGT = (const bf16_t*)(a->ws + WS_WGT);
    bf16_t* HL = (bf16_t*)(a->ws + WS_HL); bf16_t* AC = (bf16_t*)(a->ws + WS_AC); float* CSA = (float*)(a->ws + WS_CSA); float* CSH = (float*)(a->ws + WS_CSH);
    const float* cw = a->in[9] + (size_t)l * 4 * 1024; const float* cb = a->in[10] + (size_t)l * 1024;
    const float* ba = a->in[12] + (size_t)l * 1024; const float* bx = a->in[14] + (size_t)l * 1024; const float* lam = a->in[15] + (size_t)l * 1024;
    LAS unsigned char* lds = c.lds; const int tid = c.tid, lane = c.lane, w = c.wave, n = lane & 15, kq = lane >> 4;
    LAS float* XC32 = (LAS float*)(lds + A1_XC32); LAS float* A32 = (LAS float*)(lds + A1_A32); LAS float* U32 = (LAS float*)(lds + A1_U32); LAS float* SUM0 = (LAS float*)(lds + A1_SUM);
    unsigned short xr[19];
#define A1_LOAD(IT) do { const int chunk_ = (IT) >> 4, h_ = (IT) & 15, row0_ = chunk_ * 128, tseq0_ = row0_ & (SEQ - 1), r0_ = (tid >> 6) * 16; \
        const bf16_t* xp_ = P + (size_t)(row0_ + r0_) * NIN + C_XA + h_ * 64 + (tid & 63); \
        _Pragma("unroll") for (int j = 0; j < 19; ++j) xr[j] = (tseq0_ + r0_ + j - 3 >= 0) ? xp_[(ptrdiff_t)(j - 3) * NIN] : (unsigned short)0; } while (0)
    if (c.bid < 2048) A1_LOAD(c.bid);
    bf16x8 wfa[4][2], wfx[4][2]; float cw0 = 0.f, cw1 = 0.f, cw2 = 0.f, cw3 = 0.f, cbb = 0.f, gba[4], gbx[4], gsp[4]; int hcur = -1;
#pragma unroll
    for (int nt = 0; nt < 4; ++nt) { gba[nt] = 0.f; gbx[nt] = 0.f; gsp[nt] = 0.f;
#pragma unroll
        for (int ks = 0; ks < 2; ++ks) { wfa[nt][ks] = (bf16x8){0, 0, 0, 0, 0, 0, 0, 0}; wfx[nt][ks] = (bf16x8){0, 0, 0, 0, 0, 0, 0, 0}; } }
    int par = 0;
    for (int it = c.bid; it < 2048; it += c.gdim, par ^= 1) {
        const int chunk = it >> 4, h = it & 15, row0 = chunk * 128, tseq0 = row0 & (SEQ - 1);
        LAS float* SUM = SUM0 + par * 1024;
        if (h != hcur) { hcur = h;
#pragma unroll
            for (int nt = 0; nt < 4; ++nt) {
#pragma unroll
                for (int ks = 0; ks < 2; ++ks) { wfa[nt][ks] = *(const bf16x8*)(WGT + ((size_t)h * 64 + 16 * nt + n) * 64 + 32 * ks + 8 * kq);
                                                 wfx[nt][ks] = *(const bf16x8*)(WGT + ((size_t)(16 + h) * 64 + 16 * nt + n) * 64 + 32 * ks + 8 * kq); }
                const int gch = h * 64 + 16 * nt + n; const float lm = lam[gch]; gba[nt] = ba[gch]; gbx[nt] = bx[gch];
                gsp[nt] = (lm > 0.f ? 0.f : -lm) + __logf(1.0f + __expf(-fabsf(lm)));
            }
            const int gch = h * 64 + (tid & 63); cw0 = cw[gch]; cw1 = cw[1024 + gch]; cw2 = cw[2048 + gch]; cw3 = cw[3072 + gch]; cbb = cb[gch];
        }
        {
            const int ch = tid & 63, rg = tid >> 6, r0 = rg * 16;
            const float w0 = cw0, w1 = cw1, w2 = cw2, w3 = cw3, bb = cbb;
            float xm1 = bf2f(xr[2]), xm2 = bf2f(xr[1]), xm3 = bf2f(xr[0]);
#pragma unroll
            for (int r = 0; r < 16; ++r) {
                const float x0 = bf2f(xr[3 + r]);
                const float y = bb + w0 * x0 + w1 * xm1 + w2 * xm2 + w3 * xm3;
                const int row = r0 + r;
                XC32[row * 64 + ch] = y;
                *(LAS bf16_t*)(lds + A1_XCB + row * 128 + ((((ch >> 3) ^ (row & 7))) << 4) + (ch & 7) * 2) = (bf16_t)f2bf(y);
                xm3 = xm2; xm2 = xm1; xm1 = x0;
            }
        }
        A1_WSYNC();
        if (it + c.gdim < 2048) A1_LOAD(it + c.gdim);
        {
            bf16x8 af[2];
#pragma unroll
            for (int ks = 0; ks < 2; ++ks) af[ks] = *(const LAS bf16x8*)(lds + A1_XCB + (16 * w + n) * 128 + (((4 * ks + kq) ^ (n & 7)) << 4));
#pragma unroll
            for (int nt = 0; nt < 4; ++nt) {
                f32x4 aa = (f32x4){0.f, 0.f, 0.f, 0.f}, ax = (f32x4){0.f, 0.f, 0.f, 0.f};
#pragma unroll
                for (int ks = 0; ks < 2; ++ks) {
                    aa = __builtin_amdgcn_mfma_f32_16x16x32_bf16(af[ks], wfa[nt][ks], aa, 0, 0, 0);
                    ax = __builtin_amdgcn_mfma_f32_16x16x32_bf16(af[ks], wfx[nt][ks], ax, 0, 0, 0);
                }
                const int ch = 16 * nt + n; const float ba_ = gba[nt], bx_ = gbx[nt], sp = gsp[nt];
#pragma unroll
                for (int e = 0; e < 4; ++e) {
                    const int row = 16 * w + 4 * kq + e;
                    const float r = pg8::sig_f(aa[e] + ba_), ig = pg8::sig_f(ax[e] + bx_);
                    const float log_a = -8.0f * r * sp, av = __expf(log_a), z2 = 2.0f * log_a;
                    const float om = (z2 > -0.05f) ? -z2 * (1.0f + z2 * (0.5f + z2 * (0.16666667f + z2 * 0.041666668f))) : 1.0f - av * av;
                    A32[row * 68 + ch] = av; U32[row * 68 + ch] = __builtin_sqrtf(om) * (ig * XC32[row * 64 + ch]);
                }
            }
        }
        A1_WSYNC();
        const int ch = tid & 63, seg = tid >> 6, gch = h * 64 + ch;
        {
            float hh = 0.f, AA = 1.f;
#pragma unroll
            for (int r = 0; r < 16; ++r) { const int o = (seg * 16 + r) * 68 + ch; const float av = A32[o], uv = U32[o]; hh = av * hh + uv; AA *= av; A32[o] = AA; U32[o] = hh; }
            SUM[(seg * 64 + ch) * 2] = AA; SUM[(seg * 64 + ch) * 2 + 1] = hh;
        }
        A1_BAR();
        {
            float cin = 0.f, Ain = 1.f;
            for (int s2 = 0; s2 < seg; ++s2) { const float As = SUM[(s2 * 64 + ch) * 2], Hs = SUM[(s2 * 64 + ch) * 2 + 1]; cin = As * cin + Hs; Ain *= As; }
            float hl = 0.f, ac = 1.f;
#pragma unroll
            for (int r = 0; r < 16; ++r) { const int o = (seg * 16 + r) * 68 + ch; hl = U32[o] + A32[o] * cin; ac = A32[o] * Ain;
                const size_t go = (size_t)(row0 + seg * 16 + r) * 1024 + gch; HL[go] = (bf16_t)f2bf(hl); AC[go] = (bf16_t)f2bf(ac); }
            if (seg == 7) { CSA[chunk * 1024 + gch] = ac; CSH[chunk * 1024 + gch] = hl; }
        }
    }
}
#undef A1_BAR
#undef A1_WSYNC
#undef A1_LOAD
__device__ __forceinline__ void phase_carry(const Ctx& c, ArgsP a) {
    const float* CSA = (const float*)(a->ws + WS_CSA); const float* CSH = (const float*)(a->ws + WS_CSH); float* CIN = (float*)(a->ws + WS_CIN);
    for (int w = c.gw; w < 2 * 1024; w += c.NGW) {
        const int b = w >> 10, gch = w & 1023, chunk = b * 64 + c.lane;
        float A = CSA[chunk * 1024 + gch], H = CSH[chunk * 1024 + gch];
#pragma unroll
        for (int o = 1; o < 64; o <<= 1) {
            const float Ap = __shfl_up(A, o), Hp = __shfl_up(H, o);
            if (c.lane >= o) { H = A * Hp + H; A = A * Ap; }
        }
        const float hin = __shfl_up(H, 1);
        CIN[chunk * 1024 + gch] = (c.lane == 0) ? 0.f : hin;
    }
}
__device__ __forceinline__ void phase_a3(const Ctx& c, ArgsP a) {
    const bf16_t* HL = (const bf16_t*)(a->ws + WS_HL); const bf16_t* AC = (const bf16_t*)(a->ws + WS_AC); const float* CIN = (const float*)(a->ws + WS_CIN);
    const bf16_t* P = (const bf16_t*)(a->ws + WS_PROJ); bf16_t* Y0 = (bf16_t*)(a->ws + WS_Y);
    for (int i = c.gtid; i < 128 * 8 * 128; i += c.NGT) {
        const int c8 = (i & 127) * 8, rg = (i >> 7) & 7, chunk = i >> 10;
        const f32x4 ca = *(const f32x4*)(CIN + chunk * 1024 + c8), cb = *(const f32x4*)(CIN + chunk * 1024 + c8 + 4);
#pragma unroll 1
        for (int r0 = 0; r0 < 16; r0 += 8) {
            u32x4 hl[8], ac[8], ga[8];
#pragma unroll
            for (int r = 0; r < 8; ++r) { const size_t row = (size_t)chunk * 128 + rg * 16 + r0 + r; hl[r] = *(const u32x4*)(HL + row * 1024 + c8); ac[r] = *(const u32x4*)(AC + row * 1024 + c8); ga[r] = *(const u32x4*)(P + row * NIN + C_GA + c8); }
#pragma unroll
            for (int r = 0; r < 8; ++r) { const size_t row = (size_t)chunk * 128 + rg * 16 + r0 + r; u32x4 o;
                o[0] = pk2((bflo(hl[r][0]) + bflo(ac[r][0]) * ca[0]) * bflo(ga[r][0]), (bfhi(hl[r][0]) + bfhi(ac[r][0]) * ca[1]) * bfhi(ga[r][0]));
                o[1] = pk2((bflo(hl[r][1]) + bflo(ac[r][1]) * ca[2]) * bflo(ga[r][1]), (bfhi(hl[r][1]) + bfhi(ac[r][1]) * ca[3]) * bfhi(ga[r][1]));
                o[2] = pk2((bflo(hl[r][2]) + bflo(ac[r][2]) * cb[0]) * bflo(ga[r][2]), (bfhi(hl[r][2]) + bfhi(ac[r][2]) * cb[1]) * bfhi(ga[r][2]));
                o[3] = pk2((bflo(hl[r][3]) + bflo(ac[r][3]) * cb[2]) * bflo(ga[r][3]), (bfhi(hl[r][3]) + bfhi(ac[r][3]) * cb[3]) * bfhi(ga[r][3]));
                *(u32x4*)(Y0 + row * 1024 + c8) = o; }
        }
    }
}

__device__ __forceinline__ void phase_pool(const Ctx& c, ArgsP a) {
    const bf16_t* P = (const bf16_t*)(a->ws + WS_PROJ); bf16_t* PL = (bf16_t*)(a->ws + WS_PL);
    for (int i = c.gtid; i < (M / 64) * 512; i += c.NGT) {
        const int blk = i >> 9, ch = (i & 511) * 2, win = 2 << (ch >> 8), row0 = blk * 64, tseq0 = row0 & (SEQ - 1); const float rwin = 1.0f / (float)win;
        const bf16_t* xp = P + (size_t)row0 * NIN + C_XB + ch;
        float ra[16], rb[16]; float sa = 0.f, sb = 0.f;
#pragma unroll
        for (int j = 0; j < 16; ++j) { const int back = 16 - j;
            unsigned w = 0u; if (back < win && tseq0 - back >= 0) w = *(const unsigned*)(xp - (ptrdiff_t)back * NIN);
            ra[j] = bflo(w); rb[j] = bfhi(w); sa += ra[j]; sb += rb[j]; }
#pragma unroll 1
        for (int r0 = 0; r0 < 64; r0 += 32) {
            unsigned w[32];
#pragma unroll
            for (int j = 0; j < 32; ++j) w[j] = *(const unsigned*)(xp + (size_t)(r0 + j) * NIN);
#pragma unroll
            for (int j = 0; j < 32; ++j) {
                const int r = r0 + j; const float xa = bflo(w[j]), xb = bfhi(w[j]);
                const float ta = sa + xa, tb = sb + xb; const int tq = tseq0 + r; const float rc = (tq + 1 < win) ? 1.0f / (float)(tq + 1) : rwin;
                *(unsigned*)(PL + (size_t)(row0 + r) * 1024 + ch) = pk2(ta * rc - xa, tb * rc - xb);
                const float da = (win == 2) ? ra[(j + 15) & 15] : (win == 4) ? ra[(j + 13) & 15] : (win == 8) ? ra[(j + 9) & 15] : ra[(j + 1) & 15];
                const float db = (win == 2) ? rb[(j + 15) & 15] : (win == 4) ? rb[(j + 13) & 15] : (win == 8) ? rb[(j + 9) & 15] : rb[(j + 1) & 15];
                sa = ta - da; sb = tb - db; ra[j & 15] = xa; rb[j & 15] = xb;
            }
        }
    }
}

#define SG_BAR() do { asm volatile("s_waitcnt lgkmcnt(0)" ::: "memory"); __builtin_amdgcn_s_barrier(); asm volatile("" ::: "memory"); } while (0)
__device__ __forceinline__ void phase_sg(const Ctx& c, ArgsP a, int l) {
    const bf16_t* P = (const bf16_t*)(a->ws + WS_PROJ); const bf16_t* WSB = (const bf16_t*)(a->ws + WS_WSB); const float* SSV = (const float*)(a->ws + WS_SSV);
    bf16_t* Y3 = (bf16_t*)(a->ws + WS_Y) + (size_t)3 * M * 1024;
    const float* sgn = a->in[20] + (size_t)l * 1024; const float* sgb = a->in[22] + (size_t)l * 8 * 128;
    LAS unsigned char* lds = c.lds; const int tid = c.tid, lane = c.lane, w = c.wave, n = lane & 15, kq = lane >> 4;
    if (c.bid >= 1024) return;
    const int sr = tid >> 2, sq = tid & 3;
    u32x4 zv[4]; f32x4 ssp[4]; u32x2 uu[8];
#define SG_LOAD(IT) do { const int row0_ = ((IT) >> 3) * 128, g_ = (IT) & 7; const size_t row_ = (size_t)row0_ + sr; \
        _Pragma("unroll") for (int i_ = 0; i_ < 4; ++i_) { ssp[i_] = *(const f32x4*)(SSV + row_ * 16 + 4 * i_); zv[i_] = *(const u32x4*)(P + row_ * NIN + C_ZV + g_ * 128 + (4 * sq + i_) * 8); } \
        _Pragma("unroll") for (int ct_ = 0; ct_ < 8; ++ct_) uu[ct_] = *(const u32x2*)(P + ((size_t)row0_ + 16 * w + n) * NIN + C_ZU + g_ * 128 + 16 * ct_ + 4 * kq); } while (0)
    SG_LOAD(c.bid);
    int gcur = -1; bf16x8 wfa[4]; f32x4 gn[4][2]; float bt = 0.f;
    for (int it = c.bid; it < 1024; it += c.gdim) {
        const int chunk = it >> 3, g = it & 7, row0 = chunk * 128;
        if (g != gcur) {
            gcur = g;
#pragma unroll
            for (int ks = 0; ks < 4; ++ks) wfa[ks] = *(const bf16x8*)(WSB + ((size_t)g * 128 + 16 * w + n) * 128 + 32 * ks + 8 * kq);
#pragma unroll
            for (int cc = 0; cc < 4; ++cc) { gn[cc][0] = *(const f32x4*)(sgn + g * 128 + (4 * sq + cc) * 8); gn[cc][1] = *(const f32x4*)(sgn + g * 128 + (4 * sq + cc) * 8 + 4); }
            bt = sgb[g * 128 + 16 * w + n];
        }
        {
            const float ss = (((ssp[0][0] + ssp[0][1]) + (ssp[0][2] + ssp[0][3])) + ((ssp[1][0] + ssp[1][1]) + (ssp[1][2] + ssp[1][3]))) + (((ssp[2][0] + ssp[2][1]) + (ssp[2][2] + ssp[2][3])) + ((ssp[3][0] + ssp[3][1]) + (ssp[3][2] + ssp[3][3])));
            const float rs = rsqrtf(ss * (1.0f / 1024.0f) + EPS);
#pragma unroll
            for (int cc = 0; cc < 4; ++cc) {
                const int chn = 4 * sq + cc;
                const u32x4 v = zv[cc]; const f32x4 g0 = gn[cc][0], g1 = gn[cc][1];
                u32x4 o; o[0] = pk2(bflo(v[0]) * rs * g0[0], bfhi(v[0]) * rs * g0[1]); o[1] = pk2(bflo(v[1]) * rs * g0[2], bfhi(v[1]) * rs * g0[3]);
                o[2] = pk2(bflo(v[2]) * rs * g1[0], bfhi(v[2]) * rs * g1[1]); o[3] = pk2(bflo(v[3]) * rs * g1[2], bfhi(v[3]) * rs * g1[3]);
                *(LAS u32x4*)(lds + sr * 256 + ((chn ^ ((sr & 7) << 1)) << 4)) = o;
            }
        }
        u32x2 ucur[8];
#pragma unroll
        for (int ct = 0; ct < 8; ++ct) ucur[ct] = uu[ct];
        SG_BAR();
        if (it + c.gdim < 1024) SG_LOAD(it + c.gdim);
        f32x4 acc[8];
#pragma unroll
        for (int ct = 0; ct < 8; ++ct) acc[ct] = (f32x4){0.f, 0.f, 0.f, 0.f};
        const int nks = (w >> 1) + 1;
#pragma unroll
        for (int ks = 0; ks < 4; ++ks) { if (ks >= nks) break;
            const bf16x8 wf = wfa[ks];
            const int sr0 = 32 * ks + 8 * kq + (n >> 2), sr1 = sr0 + 4;
#pragma unroll
            for (int ct = 0; ct < 8; ++ct) {
                const int chn = 2 * ct + ((lane & 3) >> 1);
                const s16x4 v0 = __builtin_amdgcn_ds_read_tr16_b64_v4i16((LAS s16x4*)(lds + sr0 * 256 + ((chn ^ ((sr0 & 7) << 1)) << 4) + (lane & 1) * 8));
                const s16x4 v1 = __builtin_amdgcn_ds_read_tr16_b64_v4i16((LAS s16x4*)(lds + sr1 * 256 + ((chn ^ ((sr1 & 7) << 1)) << 4) + (lane & 1) * 8));
                const bf16x8 vf = (bf16x8){v0[0], v0[1], v0[2], v0[3], v1[0], v1[1], v1[2], v1[3]};
                acc[ct] = __builtin_amdgcn_mfma_f32_16x16x32_bf16(vf, wf, acc[ct], 0, 0, 0);
            }
        }
        {
            const int t = 16 * w + n; const size_t row = (size_t)row0 + t;
#pragma unroll
            for (int ct = 0; ct < 8; ++ct) {
                const int col = g * 128 + 16 * ct + 4 * kq;
                u32x2 o; o.x = pk2(bflo(ucur[ct].x) * (acc[ct][0] + bt), bfhi(ucur[ct].x) * (acc[ct][1] + bt)); o.y = pk2(bflo(ucur[ct].y) * (acc[ct][2] + bt), bfhi(ucur[ct].y) * (acc[ct][3] + bt));
                *(u32x2*)(Y3 + row * 1024 + col) = o;
            }
        }
        SG_BAR();
    }
}
#undef SG_BAR
#undef SG_LOAD

#define XB_TMO      128
#define XB_XCNT(j)  (256  + 64 * (j))
#define XB_XSUB(j)  (1280 + 64 * (j))
#define XB_XGEN(j)  (2304 + 64 * (j))
#define XB_TOP      3328
#define XB_TOPGEN   3392
#define XCD_BAR_WORDS 3456
#define XB_SPIN_CAP (1u << 18)

__device__ __forceinline__ unsigned xb_ld(unsigned* p)              { return __hip_atomic_load(p, __ATOMIC_RELAXED, __HIP_MEMORY_SCOPE_AGENT); }
__device__ __forceinline__ unsigned xb_add(unsigned* p, unsigned v) { return __hip_atomic_fetch_add(p, v, __ATOMIC_RELAXED, __HIP_MEMORY_SCOPE_AGENT); }
__device__ __forceinline__ unsigned xb_xcc_id() { return (unsigned)__builtin_amdgcn_s_getreg((3 << 11) | 20) & 0xFu; }
#define XB_SPIN(cond, bar) do { unsigned _sp = 0; while (cond) { __builtin_amdgcn_s_sleep(1); \
    if ((++_sp & 255u) == 0u) { if (xb_ld(&(bar)[XB_TMO])) break; if (_sp > XB_SPIN_CAP) { atomicAdd(&(bar)[XB_TMO], 1u); break; } } } } while (0)

struct XcdBarrier {
    unsigned* bar; unsigned x;
    volatile LAS unsigned* st;
};

__device__ __forceinline__ XcdBarrier xcd_barrier_post(unsigned* bar, volatile LAS unsigned* st) {
    XcdBarrier b; b.bar = bar; b.x = xb_xcc_id(); b.st = st;
    if (threadIdx.x == 0) (void)xb_add(&bar[XB_XCNT(b.x)], 1u);
    return b;
}
__device__ __forceinline__ void xcd_barrier_complete(unsigned* bar, unsigned x, unsigned& nloc, unsigned& nx) {
    const unsigned G = gridDim.x * gridDim.y * gridDim.z;
    unsigned sum, cnt, mine, sp = 0u;
    for (;;) {
        sum = 0u; cnt = 0u; mine = 0u;
#pragma unroll
        for (unsigned j = 0; j < 16; ++j) { const unsigned c = xb_ld(&bar[XB_XCNT(j)]); sum += c; cnt += (c > 0u) ? 1u : 0u; mine = (j == x) ? c : mine; }
        if (sum == G) break;
        __builtin_amdgcn_s_sleep(1);
        if ((++sp & 255u) == 0u) { if (xb_ld(&bar[XB_TMO])) break; if (sp > XB_SPIN_CAP) { atomicAdd(&bar[XB_TMO], 1u); break; } }
    }
    nloc = mine > 0u ? mine : 1u; nx = cnt > 0u ? cnt : 1u;
}

__device__ __forceinline__ void xcd_barrier(const XcdBarrier& b) {
    asm volatile("s_waitcnt vmcnt(0)" ::: "memory");
    __syncthreads();
    if (threadIdx.x == 0) {
        unsigned* bar = b.bar;
        __builtin_amdgcn_s_waitcnt(0);
        unsigned nloc = b.st[0], nx = b.st[1];
        if (nloc == 0u) { xcd_barrier_complete(bar, b.x, nloc, nx); b.st[0] = nloc; b.st[1] = nx; }
        const unsigned old = xb_add(&bar[XB_XSUB(b.x)], 1u);
        const unsigned gen = old / nloc;
        if (old + 1u == (gen + 1u) * nloc) {
            __builtin_amdgcn_fence(__ATOMIC_RELEASE, "agent");
            asm volatile("s_waitcnt vmcnt(0)" ::: "memory");
            const unsigned og = xb_add(&bar[XB_TOP], 1u);
            const unsigned tg = og / nx;
            if (og + 1u == (tg + 1u) * nx) xb_add(&bar[XB_TOPGEN], 1u);
            else XB_SPIN(xb_ld(&bar[XB_TOPGEN]) == tg, bar);
            __builtin_amdgcn_fence(__ATOMIC_ACQUIRE, "agent");
            xb_add(&bar[XB_XGEN(b.x)], 1u);
            asm volatile("s_waitcnt vmcnt(0)" ::: "memory");
        } else {
            XB_SPIN(xb_ld(&bar[XB_XGEN(b.x)]) == gen, bar);
            __builtin_amdgcn_fence(__ATOMIC_ACQUIRE, "agent");
            asm volatile("s_waitcnt vmcnt(0)" ::: "memory");
        }
    }
    __syncthreads();
}

constexpr int LDS_BYTES = 147456;
constexpr int MISC_OFF = 131072 + 320;
constexpr int CW_BAR = 4096;
constexpr size_t CTL_ZERO_BYTES = 256 * 1024;

__global__ void __launch_bounds__(NTHR, 2) mk_fwd(Args args) {
    extern __shared__ __attribute__((aligned(16))) unsigned char lds_raw[];
    LAS unsigned char* const lds = (LAS unsigned char*)lds_raw;
    volatile LAS unsigned* MISC = (volatile LAS unsigned*)(lds + MISC_OFF);
    if (threadIdx.x < 32) MISC[threadIdx.x] = 0u;
    __syncthreads();
    (void)xcd_barrier_post((unsigned*)(args.ws + WS_CTL) + CW_BAR, MISC + 8);
    const ArgsP argp0 = (ArgsP)__builtin_amdgcn_kernarg_segment_ptr();
    const int s_lo = args.s_lo, s_hi = args.s_hi;
    int s = 0;
#define STEP_BEGIN if (s_lo <= s && s < s_hi) { \
    int tid_ = threadIdx.x, l_ = l; asm volatile("" : "+v"(tid_)); asm volatile("" : "+s"(l_)); ArgsP ap = argp0; asm volatile("" : "+s"(ap)); int bid_ = blockIdx.x, gdim_ = gridDim.x; asm volatile("" : "+s"(bid_)); asm volatile("" : "+s"(gdim_)); \
    Ctx c; c.lds = lds; c.tid = tid_; c.lane = tid_ & 63; c.wave = __builtin_amdgcn_readfirstlane(tid_ >> 6); \
    c.bid = bid_; c.gdim = gdim_; c.gw = bid_ * NWAVES + c.wave; c.NGW = gdim_ * NWAVES; c.gtid = bid_ * NTHR + c.tid; c.NGT = gdim_ * NTHR; \
    unsigned char* ws = ap->ws; float* X = ap->out; bf16_t* XN = (bf16_t*)(ws + ((l_ & 1) ? WS_XN2 : WS_XN)); bf16_t* XNnext = (bf16_t*)(ws + ((l_ & 1) ? WS_XN : WS_XN2)); unsigned char* XLO = ws + WS_XLO; \
    bf16_t* PROJ = (bf16_t*)(ws + WS_PROJ); bf16_t* H = (bf16_t*)(ws + WS_H); bf16_t* Y = (bf16_t*)(ws + WS_Y); \
    float* SS = (float*)(ws + WS_SS); \
    (void)X; (void)XN; (void)XNnext; (void)XLO; (void)PROJ; (void)H; (void)Y; (void)l_; (void)SS;
#define STEP_END   if (s + 1 < s_hi) { XcdBarrier bb; bb.bar = (unsigned*)(ap->ws + WS_CTL) + CW_BAR; asm volatile("" : "+s"(bb.bar)); bb.x = xb_xcc_id(); asm volatile("" : "+s"(bb.x)); \
        bb.st = (volatile LAS unsigned*)(lds + MISC_OFF) + 8; xcd_barrier(bb); } } ++s;

    for (int l = 0; l < NL; ++l) {
        STEP_BEGIN
            phase_prep(c, ap, l_);
            if (l_ == 0) phase_init(c, ap);
        STEP_END
        for (int f = 0; f < 2; ++f) {
            STEP_BEGIN
                pg8::Gemm g{XN, (const bf16_t*)(ws + (f ? WS_W13B : WS_W13A)), 0, 0, M, 2 * F, D, D, D, 1, 0, 0}; pg8::EpiUp E{H, SS + (size_t)(l_ * 4 + 2 * f) * M * 32};
                pg8::StaticOrder S; S.init(g.M, g.N, g.nS, gdim_, bid_);
                pg8::gemm_phase<pg8::EpiUp, pg8::StaticOrder>(c.lds, g, S, E);
            STEP_END
            STEP_BEGIN
                pg8::Gemm g{H, (const bf16_t*)(ws + (f ? WS_W2B : WS_W2A)), 0, 0, M, D, F, F, F, 1, 0, 0}; pg8::EpiRes E{XN, XN, XLO, nullptr, SS + (size_t)(l_ * 4 + 2 * f + 1) * M * 32, nullptr, nullptr, 0.5f, 0};
                pg8::StaticOrder S; S.init(g.M, g.N, g.nS, gdim_, bid_, 1);
                pg8::gemm_phase<pg8::EpiRes, pg8::StaticOrder>(c.lds, g, S, E);
            STEP_END
            if (f == 0) {
                STEP_BEGIN
                    pg8::Gemm g{XN, (const bf16_t*)(ws + WS_WIN), 0, 0, M, NIN, D, D, D, 1, 0, 0}; pg8::EpiIn E{PROJ, SS + (size_t)(l_ * 4 + 1) * M * 32, (float*)(ws + WS_SSV), ap->in[8] + (size_t)l_ * 4 * D};
                    pg8::StaticOrder S; S.init(g.M, g.N, g.nS, gdim_, bid_);
                    pg8::gemm_phase<pg8::EpiIn, pg8::StaticOrder>(c.lds, g, S, E);
                STEP_END
                STEP_BEGIN
                    phase_attn(c, ap, l_);
                    phase_sg(c, ap, l_);
                    phase_a1(c, ap, l_);
                    phase_pool(c, ap);
                STEP_END
                STEP_BEGIN
                    pg8::Gemm g{(const bf16_t*)(ws + WS_PL), (const bf16_t*)(ws + WS_WPOOL), 256, 256 * 256, M, 256, 256, 1024, 256, 4, 0, 0};
                    pg8::EpiPlain E{Y + (size_t)1 * M * 1024, 1024, 256};
                    pg8::StaticOrder S; S.init(g.M, g.N, g.nS, gdim_, bid_);
                    pg8::gemm_phase<pg8::EpiPlain, pg8::StaticOrder>(c.lds, g, S, E);
                    phase_carry(c, ap);
                STEP_END
                STEP_BEGIN
                    phase_a3(c, ap);
                    phase_attn_merge(c, ap);
                STEP_END
                STEP_BEGIN
                    pg8::Gemm g{Y, (const bf16_t*)(ws + WS_WBR), (size_t)M * 1024, (size_t)D * 1024, M, D, 1024, 1024, 1024, 1, 0, 0}; pg8::EpiBr E{PROJ + C_GATE, (bf16_t*)(ws + WS_MRGB)};
                    pg8::BrOrder S; S.so.init(g.M, g.N, 1, gdim_, bid_, 1);
                    pg8::gemm_phase<pg8::EpiBr, pg8::BrOrder>(c.lds, g, S, E);
                STEP_END
                STEP_BEGIN
                    pg8::Gemm g{(const bf16_t*)(ws + WS_MRGB), (const bf16_t*)(ws + WS_WOUT), 0, 0, M, D, D, D, D, 1, 0, 0}; pg8::EpiRes E{XN, XN, XLO, nullptr, SS + (size_t)(l_ * 4 + 2) * M * 32, nullptr, nullptr, 1.0f, 0};
                    pg8::StaticOrder S; S.init(g.M, g.N, g.nS, gdim_, bid_, 1);
                    pg8::gemm_phase<pg8::EpiRes, pg8::StaticOrder>(c.lds, g, S, E);
                STEP_END
            } else {
                STEP_BEGIN
                    const bf16_t* PB = (const bf16_t*)(ws + WS_PB); const bf16_t* WPP = (const bf16_t*)(ws + WS_WPP); const bf16_t* WPG = (const bf16_t*)(ws + WS_WPG);
                    pg8::Gemm g{PB, WPP, (size_t)(XN - PB), (size_t)(WPG - WPP), M, D, D, D, D, 1, PLE, 0};
                    pg8::EpiRes E{XN, XNnext, XLO, (l_ + 1 < NL) ? nullptr : X, (l_ + 1 < NL) ? SS + (size_t)((l_ + 1) * 4) * M * 32 : nullptr, SS + (size_t)(l_ * 4 + 3) * M * 32, (const bf16_t*)(ws + WS_PP), 0.f, 1};
                    pg8::PleOrder S; S.so.init(g.M, g.N, 1, gdim_, bid_, 1);
                    pg8::gemm_phase<pg8::EpiRes, pg8::PleOrder>(c.lds, g, S, E);
                STEP_END
            }
        }
    }
#undef STEP_BEGIN
#undef STEP_END
}

#ifndef MK_PER_STEP
#define MK_PER_STEP 0
#endif
constexpr int NSTEPS_TOTAL = NL * (1 + 2 + 4 + 1 + 1 + 2 + 1);
extern "C" void kernel_launch(void* const* d_in, const int* in_sizes, int n_in, void* d_out, int out_size, void* d_ws, size_t ws_size, hipStream_t stream) {
    static int grid = 0;
    if (grid == 0) {
        if (n_in != 32 || out_size != M * D || ws_size < WS_END) { fprintf(stderr, "kernel_launch: unexpected shapes: n_in %d out %d ws %zu (need %zu)\n", n_in, out_size, ws_size, (size_t)WS_END); grid = -1; return; }
        int dev = 0, cus = 0, per_cu = 0;
        if (hipGetDevice(&dev) != hipSuccess || hipDeviceGetAttribute(&cus, hipDeviceAttributeMultiprocessorCount, dev) != hipSuccess) { grid = -1; return; }
        if (hipFuncSetAttribute((const void*)mk_fwd, hipFuncAttributeMaxDynamicSharedMemorySize, LDS_BYTES) != hipSuccess) { fprintf(stderr, "kernel_launch: hipFuncSetAttribute failed\n"); grid = -1; return; }
        if (hipOccupancyMaxActiveBlocksPerMultiprocessor(&per_cu, (const void*)mk_fwd, NTHR, LDS_BYTES) != hipSuccess || per_cu < 1) { fprintf(stderr, "kernel_launch: occupancy query says %d blocks per CU\n", per_cu); (void)hipGetLastError(); }
        grid = cus;
    }
    if (grid < 0) return;
    if (hipMemsetAsync((char*)d_ws + WS_CTL, 0, CTL_ZERO_BYTES, stream) != hipSuccess) return;
    Args a{};
    for (int i = 0; i < 32; ++i) a.in[i] = (const float*)d_in[i];
    a.out = (float*)d_out; a.ws = (unsigned char*)d_ws;
#if MK_PER_STEP
    for (int s = 0; s < NSTEPS_TOTAL; ++s) { a.s_lo = s; a.s_hi = s + 1; hipLaunchKernelGGL(mk_fwd, dim3(grid), dim3(NTHR), LDS_BYTES, stream, a); }
#else
    a.s_lo = 0; a.s_hi = NSTEPS_TOTAL;
    hipLaunchKernelGGL(mk_fwd, dim3(grid), dim3(NTHR), LDS_BYTES, stream, a);
#endif
}
```

```cpp
#include <hip/hip_runtime.h>
#include <cstdio>
#include <cstdint>

#define LAS __attribute__((address_space(3)))
#define GAS __attribute__((address_space(1)))
typedef unsigned short bf16_t;
typedef short bf16x8 __attribute__((ext_vector_type(8)));
typedef float f32x4 __attribute__((ext_vector_type(4)));
typedef float f32x2 __attribute__((ext_vector_type(2)));
typedef unsigned u32x4 __attribute__((ext_vector_type(4)));
typedef unsigned u32x2 __attribute__((ext_vector_type(2)));

constexpr int M = 16384, SEQ = 8192, D = 2048, F = 5504, NL = 4, PLE = 256, NIN = 18432;
constexpr int C_XA = 0, C_GA = 1024, C_XB = 2048, C_Q = 3072, C_K = 6144, C_V = 7168, C_ZU = 8192, C_ZV = 9216, C_GATE = 10240;
constexpr float EPS = 1e-6f;
constexpr int NWAVES = 8, NTHR = 512;

__device__ __forceinline__ unsigned f2bf(float f) { unsigned u = __builtin_bit_cast(unsigned, f); return (u + 0x7fffu + ((u >> 16) & 1u)) >> 16; }
__device__ __forceinline__ unsigned pk2(float lo, float hi) { return f2bf(lo) | (f2bf(hi) << 16); }
__device__ __forceinline__ float bf2f(unsigned short b) { return __builtin_bit_cast(float, ((unsigned)b) << 16); }
__device__ __forceinline__ float bflo(unsigned w) { return __builtin_bit_cast(float, w << 16); }
__device__ __forceinline__ float bfhi(unsigned w) { return __builtin_bit_cast(float, w & 0xffff0000u); }
__device__ __forceinline__ unsigned lo8_pack(float a, float b, float c, float d) {
    a = __builtin_amdgcn_fmed3f(a * 256.f, -224.f, 224.f); b = __builtin_amdgcn_fmed3f(b * 256.f, -224.f, 224.f); c = __builtin_amdgcn_fmed3f(c * 256.f, -224.f, 224.f); d = __builtin_amdgcn_fmed3f(d * 256.f, -224.f, 224.f);
    unsigned w = 0; w = __builtin_amdgcn_cvt_pk_fp8_f32(a, b, w, false); w = __builtin_amdgcn_cvt_pk_fp8_f32(c, d, w, true); return w;
}
__device__ __forceinline__ unsigned cvt_pk_bf16(float lo, float hi) { unsigned r; asm volatile("v_cvt_pk_bf16_f32 %0, %1, %2" : "=v"(r) : "v"(lo), "v"(hi)); return r; }
__device__ __forceinline__ float wave_sum(float v) {
#pragma unroll
    for (int o = 1; o < 64; o <<= 1) v += __shfl_xor(v, o);
    return v;
}
__device__ __forceinline__ float wave_max(float v) {
#pragma unroll
    for (int o = 1; o < 64; o <<= 1) v = fmaxf(v, __shfl_xor(v, o));
    return v;
}
__device__ __forceinline__ float sigmoidf_(float x) { return 1.0f / (1.0f + __expf(-x)); }
__device__ __forceinline__ float gelu_tanh(float x) {
    const float u = 0.7978845608028654f * (x + 0.044715f * x * x * x);
    const float t = 1.0f - 2.0f / (1.0f + __expf(2.0f * u));
    return 0.5f * x * (1.0f + t);
}
__device__ __forceinline__ float siluf_(float x) { return x / (1.0f + __expf(-x)); }

namespace pg8 {
constexpr int BM = 256, BK = 64, HALF = 128, HTB = HALF * BK * 2, STAGE_BYTES = 8 * HTB, NXCD = 8, WGM = 8;
__host__ __device__ __forceinline__ int lds_byte(int r, int c) { const int st = (r >> 4) * 2 + (c >> 5), rr = r & 15, cc = c & 31, ob = rr * 64 + cc * 2; return st * 1024 + (ob ^ (((ob >> 9) & 1) << 5)); }
__host__ __device__ __forceinline__ void stage_rc(int b, int& R, int& C) { const int st = b / 1024, sb = b % 1024, swz = sb ^ (((sb >> 9) & 1) << 5); R = (st >> 1) * 16 + swz / 64; C = (st & 1) * 32 + (swz % 64) / 2; }
__host__ __device__ __forceinline__ int perm32(int rho) { const int n = rho >> 4, i = rho & 15; return 8 * (i >> 2) + 4 * n + (i & 3); }

struct Unit { int pm, pn, sg; };
struct Gemm { const bf16_t* A; const bf16_t* Bt; size_t sgA, sgB; int M, N, K, lda, ldb, nS, K0, pad_; };

struct StaticOrder {
    int nM, nN, nS, nwg, G, c, alt;
    __device__ void init(int M_, int N_, int nS_, int G_, int c_, int alt_ = 0) { nM = M_ / BM; nN = N_ / BM; nS = nS_; nwg = nM * nN; G = G_; c = c_; alt = alt_; }
    __device__ bool next(int i, Unit& u) const {
        const int L = i * G + c; if (L >= nwg * nS) return false;
        if (nM == 64 && nS == 1) {
            const int xcd = L & 7, off = L >> 3; u.sg = 0;
            if (alt) { u.pm = 8 * xcd + (off & 3) + 4 * (off >> 5); u.pn = (off >> 2) & 7; }
            else { u.pm = 8 * xcd + (off & 7); u.pn = off >> 3; }
            return true;
        }
        int wgid = L % nwg; u.sg = L / nwg;
        { const int q = nwg / NXCD, r = nwg % NXCD, xcd = wgid % NXCD, off = wgid / NXCD; wgid = (xcd < r ? xcd * (q + 1) : r * (q + 1) + (xcd - r) * q) + off; }
        const int nig = WGM * nN, gid = wgid / nig, fm = gid * WGM, gsz = (nM - fm) < WGM ? (nM - fm) : WGM;
        u.pm = fm + ((wgid % nig) % gsz); u.pn = (wgid % nig) / gsz; return true;
    }
};

struct EpiPlain {
    static constexpr bool PERM = true, RSTD = false; const float* ss_in_unused() const { return nullptr; }
    bf16_t* O; int ldc, sgC;
    __device__ __forceinline__ bool keep(const Unit&) const { return false; }
    __device__ __forceinline__ void operator()(const f32x4 (&acc)[2][2][4][2], const Unit& u, int wr, int wc, int fr, int fq, const LAS float*) const {
        bf16_t* Ob = O + (size_t)(u.pm * BM + wr * 64 + fr) * ldc + u.pn * BM + wc * 32 + 8 * fq + u.sg * sgC;
#pragma unroll
        for (int ai = 0; ai < 2; ++ai)
#pragma unroll
            for (int m = 0; m < 4; ++m)
#pragma unroll
                for (int bj = 0; bj < 2; ++bj) { const f32x4 v0 = acc[ai][bj][m][0], v1 = acc[ai][bj][m][1];
                    u32x4 w; w.x = cvt_pk_bf16(v0[0], v0[1]); w.y = cvt_pk_bf16(v0[2], v0[3]); w.z = cvt_pk_bf16(v1[0], v1[1]); w.w = cvt_pk_bf16(v1[2], v1[3]);
                    *(u32x4*)(Ob + (size_t)(ai * HALF + m * 16) * ldc + bj * HALF) = w; }
    }
};

__device__ __forceinline__ float ld_agent(const float* p) { return __hip_atomic_load(p, __ATOMIC_RELAXED, __HIP_MEMORY_SCOPE_AGENT); }
__device__ __forceinline__ float rstd_of(const float* ssp, int row, int fq) {
    const f32x4 a = *(const f32x4*)(ssp + (size_t)row * 32 + 8 * fq), b = *(const f32x4*)(ssp + (size_t)row * 32 + 8 * fq + 4);
    float s = ((a[0] + a[1]) + (a[2] + a[3])) + ((b[0] + b[1]) + (b[2] + b[3]));
    s += __shfl_xor(s, 16); s += __shfl_xor(s, 32);
    return rsqrtf(s * (1.0f / 2048.0f) + 1e-6f);
}
__device__ __forceinline__ float gelu_f(float x) { const float u2 = x * (2.3022081981f + 0.1029432392f * x * x); return x - x * __builtin_amdgcn_rcpf(1.0f + __builtin_amdgcn_exp2f(u2)); }
__device__ __forceinline__ float sig_f(float x) { return __builtin_amdgcn_rcpf(1.0f + __expf(-x)); }

constexpr int RSTD_TAB = 135168;
__device__ __forceinline__ void fill_rstd(const float* ssp, int pm, LAS float* tab, int tid) {
    if (tid < 256) {
        const float* p = ssp + ((size_t)pm * 256 + tid) * 32; float s = 0.f;
#pragma unroll
        for (int i = 0; i < 8; ++i) { const f32x4 v = *(const f32x4*)(p + 4 * i); s += (v[0] + v[1]) + (v[2] + v[3]); }
        tab[tid] = rsqrtf(s * (1.0f / 2048.0f) + 1e-6f);
    }
    asm volatile("s_waitcnt lgkmcnt(0)" ::: "memory");
}
struct EpiUp {
    static constexpr bool PERM = true, RSTD = true;
    bf16_t* H; const float* ss_in;
    __device__ __forceinline__ void operator()(f32x4 (&acc)[2][2][4][2], const Unit& u, int wr, int wc, int fr, int fq, const LAS float* rtab) const {
        const int row0 = u.pm * BM + wr * 64 + fr, hcol0 = u.pn * 128 + wc * 32 + 8 * fq;
        float rsv[2][4];
#pragma unroll
        for (int ai = 0; ai < 2; ++ai)
#pragma unroll
            for (int m = 0; m < 4; ++m) rsv[ai][m] = rtab[wr * 64 + fr + ai * HALF + m * 16];
#pragma unroll
        for (int ai = 0; ai < 2; ++ai)
#pragma unroll
            for (int m = 0; m < 4; ++m) { const int row = row0 + ai * HALF + m * 16; const float rs = rsv[ai][m], rsl = rs * -1.4426950408889634f, rs2 = rs * rs;
                u32x4 w;
#pragma unroll
                for (int n = 0; n < 2; ++n) {
                    const f32x4 c1 = acc[ai][0][m][n], c3 = acc[ai][1][m][n]; const f32x4 t = c1 * rsl; f32x4 r;
#pragma unroll
                    for (int e = 0; e < 4; ++e) r[e] = __builtin_amdgcn_rcpf(1.0f + __builtin_amdgcn_exp2f(t[e]));
                    const f32x4 h = (c1 * c3) * (r * rs2);
                    w[2 * n] = cvt_pk_bf16(h[0], h[1]); w[2 * n + 1] = cvt_pk_bf16(h[2], h[3]); }
                *(u32x4*)(H + (size_t)row * 5504 + hcol0) = w; }
    }
    __device__ __forceinline__ bool keep(const Unit&) const { return false; }
};
struct EpiRes {
    static constexpr bool PERM = true, RSTD = true;
    const bf16_t* XHI_in; bf16_t* XHI_out; unsigned char* XLO; float* OUT32; float* ss_out; const float* ss_in; const bf16_t* PP; float alpha; int mode;
    __device__ __forceinline__ void operator()(f32x4 (&acc)[2][2][4][2], const Unit& u, int wr, int wc, int fr, int fq, const LAS float* rtab) const {
        const int row0 = u.pm * BM + wr * 64 + fr, col0 = u.pn * BM + wc * 32 + 8 * fq;
        if (mode && u.sg == 0) {
#pragma unroll
            for (int ai = 0; ai < 2; ++ai)
#pragma unroll
                for (int m = 0; m < 4; ++m)
#pragma unroll
                    for (int bj = 0; bj < 2; ++bj) { const f32x4 v0 = acc[ai][bj][m][0], v1 = acc[ai][bj][m][1];
                        u32x4 w; w[0] = cvt_pk_bf16(v0[0], v0[1]); w[1] = cvt_pk_bf16(v0[2], v0[3]); w[2] = cvt_pk_bf16(v1[0], v1[1]); w[3] = cvt_pk_bf16(v1[2], v1[3]);
                        *(u32x4*)(const_cast<bf16_t*>(PP) + (size_t)(row0 + ai * HALF + m * 16) * 2048 + col0 + bj * HALF) = w; }
            return;
        }
#pragma unroll
        for (int ai = 0; ai < 2; ++ai) {
            float rsv[4];
#pragma unroll
            for (int m = 0; m < 4; ++m) rsv[m] = mode ? rtab[wr * 64 + fr + ai * HALF + m * 16] : 0.f;
#pragma unroll
            for (int mp = 0; mp < 4; mp += 2) {
                u32x4 xh[2][2]; u32x2 xl[2][2]; u32x4 pq[2][2];
#pragma unroll
                for (int mm = 0; mm < 2; ++mm)
#pragma unroll
                    for (int bj = 0; bj < 2; ++bj) { const size_t o = (size_t)(row0 + ai * HALF + (mp + mm) * 16) * 2048 + col0 + bj * HALF;
                        xh[mm][bj] = *(const u32x4*)(XHI_in + o); xl[mm][bj] = *(const u32x2*)(XLO + o);
                        if (mode) pq[mm][bj] = *(const u32x4*)(PP + o); }
#pragma unroll
                for (int mm = 0; mm < 2; ++mm) { const int m = mp + mm; const int row = row0 + ai * HALF + m * 16; const float rs = rsv[m]; float part = 0.f;
#pragma unroll
                    for (int bj = 0; bj < 2; ++bj) { const size_t o = (size_t)row * 2048 + col0 + bj * HALF;
                        const u32x4 hh = xh[mm][bj]; const u32x2 ll = xl[mm][bj];
                        const f32x2 l01 = __builtin_amdgcn_cvt_pk_f32_fp8(ll.x, false), l23 = __builtin_amdgcn_cvt_pk_f32_fp8(ll.x, true), l45 = __builtin_amdgcn_cvt_pk_f32_fp8(ll.y, false), l67 = __builtin_amdgcn_cvt_pk_f32_fp8(ll.y, true);
                        constexpr float LS = 1.0f / 256.0f;
                        f32x4 x0 = (f32x4){bflo(hh[0]) + LS * l01[0], bfhi(hh[0]) + LS * l01[1], bflo(hh[1]) + LS * l23[0], bfhi(hh[1]) + LS * l23[1]};
                        f32x4 x1 = (f32x4){bflo(hh[2]) + LS * l45[0], bfhi(hh[2]) + LS * l45[1], bflo(hh[3]) + LS * l67[0], bfhi(hh[3]) + LS * l67[1]};
                        const f32x4 v0 = acc[ai][bj][m][0], v1 = acc[ai][bj][m][1];
                        if (mode) { const u32x4 pp = pq[mm][bj];
                            x0[0] += sig_f(rs * v0[0]) * bflo(pp[0]); x0[1] += sig_f(rs * v0[1]) * bfhi(pp[0]); x0[2] += sig_f(rs * v0[2]) * bflo(pp[1]); x0[3] += sig_f(rs * v0[3]) * bfhi(pp[1]);
                            x1[0] += sig_f(rs * v1[0]) * bflo(pp[2]); x1[1] += sig_f(rs * v1[1]) * bfhi(pp[2]); x1[2] += sig_f(rs * v1[2]) * bflo(pp[3]); x1[3] += sig_f(rs * v1[3]) * bfhi(pp[3]); }
                        else { x0 = x0 + alpha * v0; x1 = x1 + alpha * v1; }
                        u32x4 w; w[0] = cvt_pk_bf16(x0[0], x0[1]); w[1] = cvt_pk_bf16(x0[2], x0[3]); w[2] = cvt_pk_bf16(x1[0], x1[1]); w[3] = cvt_pk_bf16(x1[2], x1[3]);
                        *(u32x4*)(XHI_out + o) = w;
                        u32x2 wl; wl.x = lo8_pack(x0[0] - bflo(w[0]), x0[1] - bfhi(w[0]), x0[2] - bflo(w[1]), x0[3] - bfhi(w[1]));
                        wl.y = lo8_pack(x1[0] - bflo(w[2]), x1[1] - bfhi(w[2]), x1[2] - bflo(w[3]), x1[3] - bfhi(w[3]));
                        *(u32x2*)(XLO + o) = wl;
                        if (OUT32) { *(f32x4*)(OUT32 + o) = x0; *(f32x4*)(OUT32 + o + 4) = x1; }
                        part += (x0[0] * x0[0] + x0[1] * x0[1]) + (x0[2] * x0[2] + x0[3] * x0[3]) + (x1[0] * x1[0] + x1[1] * x1[1]) + (x1[2] * x1[2] + x1[3] * x1[3]); }
                    part += __shfl_xor(part, 16); part += __shfl_xor(part, 32);
                    if (ss_out && fq == 0) ss_out[(size_t)row * 32 + u.pn * 4 + wc] = part; }
                asm volatile("" ::: "memory");
            }
        }
    }
    __device__ __forceinline__ bool keep(const Unit&) const { return false; }
};
struct EpiIn {
    static constexpr bool PERM = true, RSTD = true;
    bf16_t* O; const float* ss_in; float* ssv; const float* bgate;
    __device__ __forceinline__ void operator()(f32x4 (&acc)[2][2][4][2], const Unit& u, int wr, int wc, int fr, int fq, const LAS float* rtab) const {
        const int row0 = u.pm * BM + wr * 64 + fr, col0 = u.pn * BM + wc * 32 + 8 * fq;
        const bool is_zv = (u.pn >= 36 && u.pn < 40);
        const bool do_gelu = (u.pn >= 4 && u.pn < 8) || (u.pn >= 32 && u.pn < 40);
        float rsv[2][4];
#pragma unroll
        for (int ai = 0; ai < 2; ++ai)
#pragma unroll
            for (int m = 0; m < 4; ++m) rsv[ai][m] = rtab[wr * 64 + fr + ai * HALF + m * 16];
        if (u.pn >= 40) {
            const int dbase = 64 * (u.pn - 40) + 16 * wc + 4 * fq;
            f32x4 bg[4];
#pragma unroll
            for (int b = 0; b < 4; ++b) bg[b] = *(const f32x4*)(bgate + b * 2048 + dbase) * -1.4426950408889634f;
#pragma unroll
            for (int ai = 0; ai < 2; ++ai)
#pragma unroll
                for (int m = 0; m < 4; ++m) { const int row = row0 + ai * HALF + m * 16; const float rs = rsv[ai][m] * -1.4426950408889634f;
                    f32x4 t[4], iv[4];
#pragma unroll
                    for (int b = 0; b < 4; ++b) { const f32x4 v = acc[ai][b >> 1][m][b & 1] * rs + bg[b];
#pragma unroll
                        for (int e = 0; e < 4; ++e) { const float x = fminf(fmaxf(v[e], -43.280851f), 43.280851f); t[b][e] = 1.0f + __builtin_amdgcn_exp2f(x); iv[b][e] = __builtin_amdgcn_rcpf(t[b][e]); } }
                    bf16_t* op = O + (size_t)row * 18432 + 10240 + dbase;
#pragma unroll
                    for (int b = 0; b < 4; ++b) { const f32x4 r = (b < 3) ? t[b + 1] * iv[b] : iv[3];
                        u32x2 w; w.x = cvt_pk_bf16(r[0], r[1]); w.y = cvt_pk_bf16(r[2], r[3]); *(u32x2*)(op + b * 2048) = w; } }
            return;
        }
#pragma unroll
        for (int ai = 0; ai < 2; ++ai)
#pragma unroll
            for (int m = 0; m < 4; ++m) { const int row = row0 + ai * HALF + m * 16; const float rs = rsv[ai][m]; float part = 0.f;
#pragma unroll
                for (int bj = 0; bj < 2; ++bj) { f32x4 v0 = acc[ai][bj][m][0] * rs, v1 = acc[ai][bj][m][1] * rs;
                    if (do_gelu) {
#pragma unroll
                        for (int e = 0; e < 4; ++e) { v0[e] = gelu_f(v0[e]); v1[e] = gelu_f(v1[e]); } }
                    u32x4 w; w[0] = cvt_pk_bf16(v0[0], v0[1]); w[1] = cvt_pk_bf16(v0[2], v0[3]); w[2] = cvt_pk_bf16(v1[0], v1[1]); w[3] = cvt_pk_bf16(v1[2], v1[3]);
                    *(u32x4*)(O + (size_t)row * 18432 + col0 + bj * HALF) = w;
                    if (is_zv) part += (v0[0] * v0[0] + v0[1] * v0[1]) + (v0[2] * v0[2] + v0[3] * v0[3]) + (v1[0] * v1[0] + v1[1] * v1[1]) + (v1[2] * v1[2] + v1[3] * v1[3]); }
                if (is_zv) { part += __shfl_xor(part, 16); part += __shfl_xor(part, 32); if (fq == 0) ssv[(size_t)row * 16 + (u.pn - 36) * 4 + wc] = part; } }
    }
    __device__ __forceinline__ bool keep(const Unit&) const { return false; }
};

struct EpiBr {
    static constexpr bool PERM = true, RSTD = false;
    const bf16_t* R; bf16_t* O;
    __device__ __forceinline__ bool keep(const Unit& u) const { return u.sg != 3; }
    __device__ __forceinline__ void operator()(f32x4 (&acc)[2][2][4][2], const Unit& u, int wr, int wc, int fr, int fq, const LAS float* rtab) const {
        const int row0 = u.pm * BM + wr * 64 + fr, col0 = u.pn * BM + wc * 32 + 8 * fq;
#pragma unroll
        for (int ai = 0; ai < 2; ++ai) {
            u32x4 rr[4][2];
#pragma unroll
            for (int m = 0; m < 4; ++m)
#pragma unroll
                for (int bj = 0; bj < 2; ++bj) rr[m][bj] = *(const u32x4*)(R + (size_t)(row0 + ai * HALF + m * 16) * 18432 + u.sg * 2048 + col0 + bj * HALF);
#pragma unroll
            for (int m = 0; m < 4; ++m) { const int row = row0 + ai * HALF + m * 16;
#pragma unroll
                for (int bj = 0; bj < 2; ++bj) { const int col = col0 + bj * HALF;
                    const u32x4 r = rr[m][bj];
                    f32x4 v0 = acc[ai][bj][m][0], v1 = acc[ai][bj][m][1];
                    v0[0] *= bflo(r[0]); v0[1] *= bfhi(r[0]); v0[2] *= bflo(r[1]); v0[3] *= bfhi(r[1]);
                    v1[0] *= bflo(r[2]); v1[1] *= bfhi(r[2]); v1[2] *= bflo(r[3]); v1[3] *= bfhi(r[3]);
                    acc[ai][bj][m][0] = v0; acc[ai][bj][m][1] = v1;
                    if (u.sg == 3) { u32x4 w; w[0] = cvt_pk_bf16(v0[0], v0[1]); w[1] = cvt_pk_bf16(v0[2], v0[3]); w[2] = cvt_pk_bf16(v1[0], v1[1]); w[3] = cvt_pk_bf16(v1[2], v1[3]);
                        *(u32x4*)(O + (size_t)row * 2048 + col) = w; } } } }
    }
};
struct PleOrder {
    StaticOrder so;
    __device__ bool next(int i, Unit& u) const { Unit t; if (!so.next(i >> 1, t)) return false; u.pm = t.pm; u.pn = t.pn; u.sg = i & 1; return true; }
};
struct BrOrder {
    StaticOrder so;
    __device__ bool next(int i, Unit& u) const { Unit t; if (!so.next(i >> 2, t)) return false; u.pm = t.pm; u.pn = t.pn; u.sg = i & 3; return true; }
};

__device__ __forceinline__ const char* uni_ptr(const char* p) {
    const unsigned long long v = (unsigned long long)p; unsigned lo = __builtin_amdgcn_readfirstlane((unsigned)v), hi = __builtin_amdgcn_readfirstlane((unsigned)(v >> 32));
    asm volatile("" : "+s"(lo), "+s"(hi));
    return (const char*)(((unsigned long long)hi << 32) | lo);
}
__device__ __forceinline__ void glds16_s(const char* sbase, unsigned voff, unsigned lds_dst) {
    unsigned keep;
    asm volatile("s_mov_b32 %0, m0\n\ts_mov_b32 m0, %3\n\ts_nop 0\n\tglobal_load_lds_dwordx4 %1, %2\n\ts_mov_b32 m0, %0" : "=&s"(keep) : "v"(voff), "s"(sbase), "s"(lds_dst) : "memory");
}
template <class Epi, class Sched>
__device__ __forceinline__ void gemm_phase(LAS unsigned char* lds, const Gemm g, const Sched& S, const Epi& E) {
    int tid_ = threadIdx.x; asm volatile("" : "+v"(tid_));
    const int tid = tid_, wid = __builtin_amdgcn_readfirstlane(tid >> 6), lane = tid & 63, wr = wid >> 2, wc = wid & 3, fr = lane & 15, fq = lane >> 4;
    unsigned voffA[2], voffB[2];
#pragma unroll
    for (int i = 0; i < 2; ++i) { int R, C; stage_rc(tid * 16 + i * 8192, R, C); const int Rb = Epi::PERM ? ((R & ~31) + perm32(R & 31)) : R;
        voffA[i] = (unsigned)(R * g.lda + C) * 2u; voffB[i] = (unsigned)(Rb * g.ldb + C) * 2u; }
    constexpr unsigned kstep = BK * 2;
    const unsigned hstepA = (unsigned)HALF * g.lda * 2u, hstepB = (unsigned)HALF * g.ldb * 2u;
    const unsigned tstepA = 2u * hstepA, tstepB = 2u * hstepB;
    const unsigned ldsw = (unsigned)wid * 1024u;
    const unsigned ldsbase = (unsigned)(size_t)lds + ldsw;
    const int aoff = lds_byte(wr * 64 + fr, fq * 8), boff = lds_byte(wc * 32 + fr, fq * 8);
#define PG8_SA(b, h) (((b) * 2 + (h)) * HTB)
#define PG8_SB(b, h) ((4 + (b) * 2 + (h)) * HTB)
#define PG8_STAGE(bufoff, gbase, voff) do { const char* _gb = uni_ptr((const char*)(gbase)); _Pragma("unroll") for (int _i = 0; _i < 2; ++_i) \
        glds16_s(_gb, (voff)[_i], ldsbase + (unsigned)((bufoff) + _i * 8192)); } while (0)
#define PG8_LDA(dst, b, h) do { _Pragma("unroll") for (int m = 0; m < 4; ++m) _Pragma("unroll") for (int k = 0; k < 2; ++k) dst[m][k] = *(const LAS bf16x8*)(lds + PG8_SA(b, h) + aoff + m * 2048 + k * 1024); } while (0)
#define PG8_LDB(dst, b, h) do { _Pragma("unroll") for (int n = 0; n < 2; ++n) _Pragma("unroll") for (int k = 0; k < 2; ++k) dst[n][k] = *(const LAS bf16x8*)(lds + PG8_SB(b, h) + boff + n * 2048 + k * 1024); } while (0)
#define PG8_MMA(ai, bj, At, Bt) do { __builtin_amdgcn_s_setprio(1); _Pragma("unroll") for (int m = 0; m < 4; ++m) _Pragma("unroll") for (int n = 0; n < 2; ++n) _Pragma("unroll") for (int k = 0; k < 2; ++k) \
        acc[ai][bj][m][n] = __builtin_amdgcn_mfma_f32_16x16x32_bf16(Bt[n][k], At[m][k], acc[ai][bj][m][n], 0, 0, 0); __builtin_amdgcn_s_setprio(0); } while (0)
#define PG8_WAIT_V(n) asm volatile("s_waitcnt vmcnt(" #n ")" ::: "memory")
#define PG8_WAIT_L(n) asm volatile("s_waitcnt lgkmcnt(" #n ")" ::: "memory")
#define PG8_BAR __builtin_amdgcn_s_barrier()
#define PG8_SCHED __builtin_amdgcn_sched_barrier(0)
    Unit cur, nxt; int ui = 0;
    if (!S.next(0, cur)) return;
    LAS float* const rtab = (LAS float*)(lds + RSTD_TAB);
    int tab_pm = -1;
    if constexpr (Epi::RSTD) { if (E.ss_in) { fill_rstd(E.ss_in, cur.pm, rtab, tid); tab_pm = cur.pm; } }
    f32x4 acc[2][2][4][2];
#pragma unroll
    for (int a = 0; a < 2; ++a)
#pragma unroll
        for (int b = 0; b < 2; ++b)
#pragma unroll
            for (int m = 0; m < 4; ++m)
#pragma unroll
                for (int n = 0; n < 2; ++n) acc[a][b][m][n] = (f32x4){0.f, 0.f, 0.f, 0.f};
    bf16x8 At[4][2], B0[2][2], B1[2][2];
    const char* cA = (const char*)(g.A + (size_t)cur.sg * g.sgA) + (size_t)((unsigned)cur.pm * tstepA); const char* cB = (const char*)(g.Bt + (size_t)cur.sg * g.sgB) + (size_t)((unsigned)cur.pn * tstepB);
    PG8_STAGE(PG8_SB(0, 0), cB, voffB); PG8_STAGE(PG8_SB(0, 1), cB + hstepB, voffB); PG8_STAGE(PG8_SA(0, 0), cA, voffA); PG8_STAGE(PG8_SA(0, 1), cA + hstepA, voffA);
    if (wr == 1) PG8_BAR;
    PG8_WAIT_V(2); PG8_BAR;
    PG8_STAGE(PG8_SB(1, 0), cB + kstep, voffB); PG8_STAGE(PG8_SA(1, 0), cA + kstep, voffA); PG8_STAGE(PG8_SB(1, 1), cB + hstepB + kstep, voffB);
    PG8_WAIT_V(6); PG8_BAR;
    for (;;) {
        const int nt = ((g.K0 != 0 && cur.sg == 0) ? g.K0 : g.K) / BK;
        const bool has_next = S.next(ui + 1, nxt);
        const char* nA = has_next ? (const char*)(g.A + (size_t)nxt.sg * g.sgA) + (size_t)((unsigned)nxt.pm * tstepA) : cA;
        const char* nB = has_next ? (const char*)(g.Bt + (size_t)nxt.sg * g.sgB) + (size_t)((unsigned)nxt.pn * tstepB) : cB;
        for (int t = 0; t < nt; t += 2) {
            const bool last = (t == nt - 2);
            const char* a1 = cA + (unsigned)(t + 1) * kstep;
            const char* a2 = last ? nA : cA + (unsigned)(t + 2) * kstep; const char* b2 = last ? nB : cB + (unsigned)(t + 2) * kstep;
            const char* a3 = a2 + kstep; const char* b3 = b2 + kstep;
            PG8_LDB(B0, 0, 0); PG8_LDB(B1, 0, 1); PG8_SCHED; PG8_LDA(At, 0, 0); PG8_STAGE(PG8_SA(1, 1), a1 + hstepA, voffA);
            PG8_WAIT_V(8); PG8_WAIT_L(0); PG8_BAR; PG8_MMA(0, 0, At, B0); PG8_MMA(0, 1, At, B1); PG8_BAR; PG8_SCHED;
            PG8_LDA(At, 0, 1); PG8_STAGE(PG8_SB(0, 0), b2, voffB); PG8_STAGE(PG8_SB(0, 1), b2 + hstepB, voffB); PG8_STAGE(PG8_SA(0, 0), a2, voffA);
            PG8_WAIT_V(8); PG8_WAIT_L(0); PG8_BAR; PG8_MMA(1, 0, At, B0); PG8_MMA(1, 1, At, B1); PG8_BAR; PG8_SCHED;
            PG8_LDB(B0, 1, 0); PG8_LDB(B1, 1, 1); PG8_SCHED; PG8_LDA(At, 1, 0); PG8_STAGE(PG8_SA(0, 1), a2 + hstepA, voffA);
            PG8_WAIT_V(8); PG8_WAIT_L(0); PG8_BAR; PG8_MMA(0, 0, At, B0); PG8_MMA(0, 1, At, B1); PG8_BAR; PG8_SCHED;
            PG8_LDA(At, 1, 1); PG8_STAGE(PG8_SB(1, 0), b3, voffB); PG8_STAGE(PG8_SB(1, 1), b3 + hstepB, voffB); PG8_STAGE(PG8_SA(1, 0), a3, voffA);
            PG8_WAIT_V(8); PG8_WAIT_L(0); PG8_BAR; PG8_MMA(1, 0, At, B0); PG8_MMA(1, 1, At, B1); PG8_BAR; PG8_SCHED;
        }
        if (wr == 0) PG8_BAR;
        if constexpr (Epi::RSTD) { if (E.ss_in && cur.pm != tab_pm) { fill_rstd(E.ss_in, cur.pm, rtab, tid); PG8_BAR; tab_pm = cur.pm; } }
        E(acc, cur, wr, wc, fr, fq, rtab);
        if (!has_next) break;
        if (!E.keep(cur)) {
#pragma unroll
        for (int a = 0; a < 2; ++a)
#pragma unroll
            for (int b = 0; b < 2; ++b)
#pragma unroll
                for (int m = 0; m < 4; ++m)
#pragma unroll
                    for (int n = 0; n < 2; ++n) acc[a][b][m][n] = (f32x4){0.f, 0.f, 0.f, 0.f};
        }
        cur = nxt; cA = nA; cB = nB; ++ui;
        if (wr == 1) PG8_BAR;
    }
    PG8_WAIT_V(0);
    PG8_BAR;
#undef PG8_SA
#undef PG8_SB
#undef PG8_STAGE
#undef PG8_LDA
#undef PG8_LDB
#undef PG8_MMA
#undef PG8_WAIT_V
#undef PG8_WAIT_L
#undef PG8_BAR
#undef PG8_SCHED
}
}

constexpr size_t MiB = 1u << 20;
constexpr size_t al(size_t x) { return (x + 4095) & ~(size_t)4095; }
constexpr size_t SZ_W13 = (size_t)2 * F * D * 2, SZ_W2 = (size_t)D * F * 2, SZ_WIN = (size_t)NIN * D * 2, SZ_WBR = (size_t)4 * D * 1024 * 2, SZ_WOUT = (size_t)D * D * 2,
                 SZ_WPG = (size_t)D * D * 2, SZ_WPP = (size_t)D * 2048 * 2  , SZ_WPOOL = (size_t)4 * 256 * 256 * 2;
constexpr size_t WS_CTL = 0;
constexpr size_t WS_W13A = 1 * MiB;
constexpr size_t WS_W2A = WS_W13A + al(SZ_W13);
constexpr size_t WS_WIN = WS_W2A + al(SZ_W2);
constexpr size_t WS_WBR = WS_WIN + al(SZ_WIN);
constexpr size_t WS_WOUT = WS_WBR + al(SZ_WBR);
constexpr size_t WS_W13B = WS_WOUT + al(SZ_WOUT);
constexpr size_t WS_W2B = WS_W13B + al(SZ_W13);
constexpr size_t WS_WPG = WS_W2B + al(SZ_W2);
constexpr size_t WS_WPP = WS_WPG + al(SZ_WPG);
constexpr size_t WS_WPOOL = WS_WPP + al(SZ_WPP);
constexpr size_t WS_WGT = WS_WPOOL + al(SZ_WPOOL);
constexpr size_t WS_WSB = WS_WGT + al((size_t)2 * 16 * 64 * 64 * 2);
constexpr size_t WS_PB = WS_WSB + al((size_t)8 * 128 * 128 * 2);
constexpr size_t WS_XN = WS_PB + al((size_t)M * 2048 * 2);
constexpr size_t WS_XN2 = WS_XN + al((size_t)M * D * 2);
constexpr size_t WS_XLO = WS_XN2 + al((size_t)M * D * 2);
constexpr size_t WS_PROJ = WS_XLO + al((size_t)M * D * 2);
constexpr size_t WS_H = WS_PROJ;
constexpr size_t WS_PL = WS_PROJ + al((size_t)M * NIN * 2);
constexpr size_t WS_Y = WS_PL + al((size_t)M * 1024 * 2);
constexpr size_t WS_MRGB = WS_Y + al((size_t)4 * M * 1024 * 2);
constexpr size_t WS_OG = WS_MRGB + al((size_t)M * D * 2);
constexpr size_t WS_LSE = WS_OG + al((size_t)3 * M * 1024 * 2);
constexpr size_t WS_SS = WS_LSE + al((size_t)3 * M * 8 * 4);
constexpr size_t WS_PP = WS_SS + al((size_t)(NL * 4 + 1) * M * 32 * 4);
constexpr size_t WS_HL = WS_PP + al((size_t)M * D * 2);
constexpr size_t WS_AC = WS_HL + al((size_t)M * 1024 * 2);
constexpr size_t WS_CSA = WS_AC + al((size_t)M * 1024 * 2);
constexpr size_t WS_CSH = WS_CSA + al((size_t)128 * 1024 * 4);
constexpr size_t WS_SSV = WS_CSH + al((size_t)128 * 1024 * 4);
constexpr size_t WS_CIN = WS_SSV + al((size_t)M * 16 * 4);
constexpr size_t WS_END = WS_CIN + al((size_t)128 * 1024 * 4);
static_assert((size_t)M * F * 2 <= (size_t)M * NIN * 2, "H overlay fits inside PROJ");

struct Args { const float* in[32]; float* out; unsigned char* ws; int s_lo, s_hi; };
typedef const Args __attribute__((address_space(4)))* ArgsP;

struct Ctx { int tid, lane, wave, gw, NGW, gtid, NGT, bid, gdim; LAS unsigned char* lds; };

__device__ __forceinline__ void tr_item(const float* W, int ldw, int k0, int n0, bf16_t* WT, int ldt, int drow0, const float* ksc, const float* nsc, LAS float* scr, int lane) {
    {
        const int c4 = (lane & 7) * 4; f32x4 v[8];
#pragma unroll
        for (int i = 0; i < 8; ++i) v[i] = *(const f32x4*)(W + (size_t)(k0 + 8 * i + (lane >> 3)) * ldw + n0 + c4);
        f32x4 ns = (f32x4){1.f, 1.f, 1.f, 1.f}; if (nsc) ns = *(const f32x4*)(nsc + n0 + c4);
#pragma unroll
        for (int i = 0; i < 8; ++i) { const int kk = 8 * i + (lane >> 3); f32x4 x = v[i] * ns; if (ksc) x = x * ksc[k0 + kk];
            scr[kk * 33 + c4] = x[0]; scr[kk * 33 + c4 + 1] = x[1]; scr[kk * 33 + c4 + 2] = x[2]; scr[kk * 33 + c4 + 3] = x[3]; }
    }
    asm volatile("s_waitcnt lgkmcnt(0)" ::: "memory");
    const int c = lane & 7;
#pragma unroll
    for (int j = 0; j < 4; ++j) { const int n = (lane >> 3) + 8 * j; const LAS float* s = scr + (8 * c) * 33 + n;
        u32x4 o; o.x = pk2(s[0 * 33], s[1 * 33]); o.y = pk2(s[2 * 33], s[3 * 33]); o.z = pk2(s[4 * 33], s[5 * 33]); o.w = pk2(s[6 * 33], s[7 * 33]);
        int dr = drow0 + n;
        if (drow0 < 0) {
            const int gcol = n0 + n - C_GATE, b = gcol >> 11, d = gcol & 2047, dl = d & 63;
            dr = C_GATE + 256 * (d >> 6) + 128 * (b >> 1) + 32 * (dl >> 4) + 8 * ((dl >> 2) & 3) + 4 * (b & 1) + (dl & 3);
        }
        *(u32x4*)(WT + (size_t)dr * ldt + k0 + 8 * c) = o; }
    asm volatile("s_waitcnt lgkmcnt(0)" ::: "memory");
}
__device__ __forceinline__ void tr_matrix(const Ctx& c, int& base, const float* W, int K, int N, bf16_t* WT, const float* ksc, int mode  , const float* nsc = nullptr, int ldt = 0) {
    LAS float* scr = (LAS float*)(c.lds + c.wave * 16384);
    const int nblk = N / 32, nitems = (K / 64) * nblk;
    int first = (c.gw - base) % c.NGW; if (first < 0) first += c.NGW;
    base = (base + nitems) % c.NGW;
    for (int it = first; it < nitems; it += c.NGW) {
        const int kb = it / nblk, nb = it % nblk, k0 = 64 * kb, n0 = 32 * nb;
        int drow0 = n0;
        if (mode == 1 || mode == 2) drow0 = (n0 / 128) * 256 + (n0 % 128) + (mode == 2 ? 128 : 0);
        if (mode == 3 && n0 >= C_GATE) drow0 = -1;
        tr_item(W, N, k0, n0, WT, ldt ? ldt : K, drow0, ksc, nsc, scr, c.lane);
    }
}

__device__ __forceinline__ void phase_prep(const Ctx& c, ArgsP a, int l) {
    unsigned char* ws = a->ws; int base = 0;
    tr_matrix(c, base, a->in[3] + (size_t)l * D * F, D, F, (bf16_t*)(ws + WS_W13A), a->in[2] + (size_t)l * D, 1);
    tr_matrix(c, base, a->in[4] + (size_t)l * D * F, D, F, (bf16_t*)(ws + WS_W13A), a->in[2] + (size_t)l * D, 2);
    tr_matrix(c, base, a->in[5] + (size_t)l * F * D, F, D, (bf16_t*)(ws + WS_W2A), nullptr, 0);
    tr_matrix(c, base, a->in[7] + (size_t)l * D * NIN, D, NIN, (bf16_t*)(ws + WS_WIN), a->in[6] + (size_t)l * D, 3);
    for (int b = 0; b < 4; ++b) tr_matrix(c, base, a->in[23] + ((size_t)l * 4 + b) * 1024 * D, 1024, D, (bf16_t*)(ws + WS_WBR) + (size_t)b * D * 1024, nullptr, 0);
    tr_matrix(c, base, a->in[24] + (size_t)l * D * D, D, D, (bf16_t*)(ws + WS_WOUT), nullptr, 0);
    tr_matrix(c, base, a->in[26] + (size_t)l * D * F, D, F, (bf16_t*)(ws + WS_W13B), a->in[25] + (size_t)l * D, 1);
    tr_matrix(c, base, a->in[27] + (size_t)l * D * F, D, F, (bf16_t*)(ws + WS_W13B), a->in[25] + (size_t)l * D, 2);
    tr_matrix(c, base, a->in[28] + (size_t)l * F * D, F, D, (bf16_t*)(ws + WS_W2B), nullptr, 0);
    tr_matrix(c, base, a->in[30] + (size_t)l * D * D, D, D, (bf16_t*)(ws + WS_WPG), a->in[29] + (size_t)l * D, 0);
    tr_matrix(c, base, a->in[31] + (size_t)l * PLE * D, PLE, D, (bf16_t*)(ws + WS_WPP), nullptr, 0, nullptr, 2048);
    for (int g = 0; g < 4; ++g) tr_matrix(c, base, a->in[16] + ((size_t)l * 4 + g) * 256 * 256, 256, 256, (bf16_t*)(ws + WS_WPOOL) + (size_t)g * 256 * 256, nullptr, 0, a->in[17] + (size_t)l * 1024 + g * 256);
    for (int hh = 0; hh < 16; ++hh) {
        tr_matrix(c, base, a->in[11] + ((size_t)l * 16 + hh) * 4096, 64, 64, (bf16_t*)(ws + WS_WGT) + (size_t)hh * 4096, nullptr, 0);
        tr_matrix(c, base, a->in[13] + ((size_t)l * 16 + hh) * 4096, 64, 64, (bf16_t*)(ws + WS_WGT) + (size_t)(16 + hh) * 4096, nullptr, 0);
    }
    {
        const float* sw = a->in[21] + (size_t)l * 8 * 128 * 128; bf16_t* wsb = (bf16_t*)(ws + WS_WSB);
        for (int i = c.gtid; i < 8 * 128 * 128; i += c.NGT) { const int t = (i >> 7) & 127, s = i & 127; wsb[i] = (s <= t) ? (bf16_t)f2bf(sw[i]) : (bf16_t)0; }
    }
    {
        const float* p = a->in[1] + (size_t)l * M * PLE; bf16_t* pb = (bf16_t*)(ws + WS_PB);
        for (int i = c.gtid; i < M * PLE / 4; i += c.NGT) { const f32x4 v = *(const f32x4*)(p + 4 * (size_t)i); const int m = i >> 6, cc = (i & 63) * 4;
            u32x2 w; w.x = pk2(v[0], v[1]); w.y = pk2(v[2], v[3]); *(u32x2*)(pb + (size_t)m * 2048 + cc) = w; }
    }
}

__device__ __forceinline__ void phase_init(const Ctx& c, ArgsP a) {
    const float* xin = a->in[0]; bf16_t* XB = (bf16_t*)(a->ws + WS_XN); unsigned char* XL = a->ws + WS_XLO; float* SS = (float*)(a->ws + WS_SS);
    for (int m = c.gw; m < M; m += c.NGW) {
        float ss = 0.f;
#pragma unroll
        for (int j = 0; j < 8; ++j) { const size_t o = (size_t)m * D + 256 * j + 4 * c.lane; const f32x4 x = *(const f32x4*)(xin + o);
            u32x2 w; w.x = pk2(x[0], x[1]); w.y = pk2(x[2], x[3]); *(u32x2*)(XB + o) = w;
            *(unsigned*)(XL + o) = lo8_pack(x[0] - bflo(w.x), x[1] - bfhi(w.x), x[2] - bflo(w.y), x[3] - bfhi(w.y));
            ss += (x[0] * x[0] + x[1] * x[1]) + (x[2] * x[2] + x[3] * x[3]); }
        ss = wave_sum(ss);
        if (c.lane < 32) SS[(size_t)m * 32 + c.lane] = (c.lane == 0) ? ss : 0.f;
    }
}

typedef short s16x4 __attribute__((ext_vector_type(4)));
constexpr int ATT_K_OFF = 0, ATT_V_OFF = 65536, ATT_RK_OFF = 132096;
struct AttItem { int b, h, g, r, nb, dsh, rowb; };
__device__ __forceinline__ AttItem att_decode(int it) {
    AttItem t; t.h = it & 7; const int rest = it >> 3, q48 = rest % 192, span = q48 / 48, jj = q48 % 48, e16 = jj & 15;
    t.b = rest / 192; t.g = jj >> 4; t.dsh = 2 * t.g; t.rowb = t.b * SEQ;
    t.r = (t.g == 0) ? 0 : (t.g == 1 ? (e16 & 3) : e16); t.nb = (t.g == 0) ? span * 16 + e16 : (t.g == 1 ? span * 4 + (e16 >> 2) : span);
    return t;
}
template <int VT> __device__ __forceinline__ void att_dma(const bf16_t* P, const AttItem& t, LAS unsigned char* lds, int w, int lane) {
#pragma unroll
    for (int i = 0; i < 8; ++i) {
        const int q = w * 8 + i, trow = 4 * q + (lane >> 4), pc = lane & 15;
        int pos = ((128 * (t.nb - 1) + trow) << t.dsh) + t.r; if (pos < 0) pos = t.r;
        const bf16_t* src = P + (size_t)(t.rowb + pos) * NIN + t.h * 128;
        if (VT == 0) __builtin_amdgcn_global_load_lds((const unsigned*)(src + C_K + ((pc ^ (trow & 15)) << 3)), (LAS unsigned*)(lds + ATT_K_OFF + q * 1024), 16, 0, 0);
        else         __builtin_amdgcn_global_load_lds((const unsigned*)(src + C_V + ((pc ^ ((trow & 7) << 1)) << 3)), (LAS unsigned*)(lds + ATT_V_OFF + q * 1024), 16, 0, 0);
    }
}
constexpr int ATT_GT_OFF = 133120;
__device__ __forceinline__ void att_qprep(const u32x4 (&qraw)[4], LAS unsigned char* lds, int kq, bf16x8 (&qf)[4], float& rq) {
    float ssq = 0.f;
#pragma unroll
    for (int ks = 0; ks < 4; ++ks) {
        const u32x4 qr = qraw[ks];
        const f32x4 ga = *(const LAS f32x4*)(lds + ATT_GT_OFF + (32 * ks + 8 * kq) * 4), gb = *(const LAS f32x4*)(lds + ATT_GT_OFF + (32 * ks + 8 * kq + 4) * 4);
        u32x4 o; float lo, hi;
        lo = bflo(qr[0]); hi = bfhi(qr[0]); ssq += lo * lo + hi * hi; o[0] = pk2(lo * ga[0], hi * ga[1]);
        lo = bflo(qr[1]); hi = bfhi(qr[1]); ssq += lo * lo + hi * hi; o[1] = pk2(lo * ga[2], hi * ga[3]);
        lo = bflo(qr[2]); hi = bfhi(qr[2]); ssq += lo * lo + hi * hi; o[2] = pk2(lo * gb[0], hi * gb[1]);
        lo = bflo(qr[3]); hi = bfhi(qr[3]); ssq += lo * lo + hi * hi; o[3] = pk2(lo * gb[2], hi * gb[3]);
        qf[ks] = __builtin_bit_cast(bf16x8, o);
    }
    ssq += __shfl_xor(ssq, 16); ssq += __shfl_xor(ssq, 32);
    rq = rsqrtf(ssq * (1.0f / 128.0f) + EPS);
}
#define ATT_BAR() do { asm volatile("s_waitcnt lgkmcnt(0)" ::: "memory"); __builtin_amdgcn_s_barrier(); asm volatile("" ::: "memory"); } while (0)
__device__ __forceinline__ void phase_attn(const Ctx& c, ArgsP a, int l) {
    const bf16_t* P = (const bf16_t*)(a->ws + WS_PROJ); bf16_t* OG = (bf16_t*)(a->ws + WS_OG); float* LSE = (float*)(a->ws + WS_LSE);
    const float* qg = a->in[18] + (size_t)l * 128; const float* kg = a->in[19] + (size_t)l * 128;
    const int w = c.wave, lane = c.lane, n = lane & 15, kq = lane >> 4;
    LAS unsigned char* lds = c.lds;
    int it = c.bid; if (it >= 3072) return;
    if (c.tid < 128) *(LAS float*)(lds + ATT_GT_OFF + c.tid * 4) = qg[c.tid] * kg[c.tid] * 0.08838834764831845f;
    ATT_BAR();
    AttItem cur = att_decode(it);
    u32x4 qraw[4]; bf16x8 qf[4]; float rq;
    att_dma<0>(P, cur, lds, w, lane);
    { const size_t qrow0 = (size_t)cur.rowb + (((128 * cur.nb + 16 * w + n) << cur.dsh) + cur.r);
#pragma unroll
      for (int ks = 0; ks < 4; ++ks) qraw[ks] = *(const u32x4*)(P + qrow0 * NIN + C_Q + (cur.g * 8 + cur.h) * 128 + 32 * ks + 8 * kq); }
    asm volatile("s_waitcnt vmcnt(0)" ::: "memory");
    att_qprep(qraw, lds, kq, qf, rq);
    att_dma<1>(P, cur, lds, w, lane);
    for (;;) {
        const int itn = it + c.gdim; const bool has_next = itn < 3072; const AttItem nxt = att_decode(has_next ? itn : it);
        const int h = cur.h, g = cur.g, nb = cur.nb;
        const size_t qrow = (size_t)cur.rowb + (((128 * nb + 16 * w + n) << cur.dsh) + cur.r);
        ATT_BAR();
        {
            const int krow = c.tid >> 1, hf = c.tid & 1; float s = 0.f;
#pragma unroll
            for (int cc = 0; cc < 8; ++cc) { const u32x4 kv = *(const LAS u32x4*)(lds + ATT_K_OFF + krow * 256 + ((hf * 8 + cc) << 4));
#pragma unroll
                for (int e = 0; e < 4; ++e) { const float lo = bflo(kv[e]), hi = bfhi(kv[e]); s += lo * lo + hi * hi; } }
            s += __shfl_xor(s, 1);
            if (hf == 0) *(LAS float*)(lds + ATT_RK_OFF + krow * 4) = rsqrtf(s * (1.0f / 128.0f) + EPS);
        }
        f32x4 st[9];
#pragma unroll
        for (int T = 0; T < 9; ++T) {
            f32x4 acc = (f32x4){0.f, 0.f, 0.f, 0.f};
#pragma unroll
            for (int ks = 0; ks < 4; ++ks) {
                const bf16x8 kf = *(const LAS bf16x8*)(lds + ATT_K_OFF + (16 * (w + T) + n) * 256 + (((4 * ks + kq) ^ n) << 4));
                acc = __builtin_amdgcn_mfma_f32_16x16x32_bf16(kf, qf[ks], acc, 0, 0, 0);
            }
            st[T] = acc;
        }
        ATT_BAR();
        if (has_next) {
            const size_t qrown = (size_t)nxt.rowb + (((128 * nxt.nb + 16 * w + n) << nxt.dsh) + nxt.r);
#pragma unroll
            for (int ks = 0; ks < 4; ++ks) qraw[ks] = *(const u32x4*)(P + qrown * NIN + C_Q + (nxt.g * 8 + nxt.h) * 128 + 32 * ks + 8 * kq);
            att_dma<0>(P, nxt, lds, w, lane);
        }
        float mx = -1e30f;
#pragma unroll
        for (int T = 0; T < 9; ++T) {
            const f32x4 rk4 = *(const LAS f32x4*)(lds + ATT_RK_OFF + (16 * (w + T) + 4 * kq) * 4);
#pragma unroll
            for (int e = 0; e < 4; ++e) {
                const int kl = 16 * T + 4 * kq + e;
                const bool valid = (kl >= n) && (kl <= n + 128) && (nb > 0 || 16 * w + kl >= 128);
                const float s = valid ? st[T][e] * rk4[e] * rq : -1e30f;
                st[T][e] = s; mx = fmaxf(mx, s);
            }
        }
        mx = fmaxf(mx, __shfl_xor(mx, 16)); mx = fmaxf(mx, __shfl_xor(mx, 32));
        float sum = 0.f;
#pragma unroll
        for (int T = 0; T < 9; ++T)
#pragma unroll
            for (int e = 0; e < 4; ++e) { const float p = (st[T][e] > -1e29f) ? __expf(st[T][e] - mx) : 0.f; st[T][e] = p; sum += p; }
        sum += __shfl_xor(sum, 16); sum += __shfl_xor(sum, 32);
        if (has_next) asm volatile("s_waitcnt vmcnt(8)" ::: "memory"); else asm volatile("s_waitcnt vmcnt(0)" ::: "memory");
        ATT_BAR();
        f32x4 oacc[8];
#pragma unroll
        for (int dt = 0; dt < 8; ++dt) oacc[dt] = (f32x4){0.f, 0.f, 0.f, 0.f};
#pragma unroll
        for (int p = 0; p < 5; ++p) {
            const int T0 = 2 * p, T1 = (2 * p + 1 <= 8) ? 2 * p + 1 : 8;
            u32x4 pw; pw[0] = pk2(st[T0][0], st[T0][1]); pw[1] = pk2(st[T0][2], st[T0][3]);
            if (2 * p + 1 <= 8) { pw[2] = pk2(st[T1][0], st[T1][1]); pw[3] = pk2(st[T1][2], st[T1][3]); } else { pw[2] = 0u; pw[3] = 0u; }
            const bf16x8 pf = __builtin_bit_cast(bf16x8, pw);
            const int vr0 = 16 * (w + T0) + 4 * kq + (n >> 2), vr1 = 16 * (w + T1) + 4 * kq + (n >> 2);
#pragma unroll
            for (int dt = 0; dt < 8; ++dt) {
                const int ch = 2 * dt + ((lane & 3) >> 1);
                const s16x4 v0 = __builtin_amdgcn_ds_read_tr16_b64_v4i16((LAS s16x4*)(lds + ATT_V_OFF + vr0 * 256 + ((ch ^ ((vr0 & 7) << 1)) << 4) + (lane & 1) * 8));
                const s16x4 v1 = __builtin_amdgcn_ds_read_tr16_b64_v4i16((LAS s16x4*)(lds + ATT_V_OFF + vr1 * 256 + ((ch ^ ((vr1 & 7) << 1)) << 4) + (lane & 1) * 8));
                const bf16x8 vf = (bf16x8){v0[0], v0[1], v0[2], v0[3], v1[0], v1[1], v1[2], v1[3]};
                oacc[dt] = __builtin_amdgcn_mfma_f32_16x16x32_bf16(vf, pf, oacc[dt], 0, 0, 0);
            }
        }
        ATT_BAR();
        asm volatile("s_waitcnt vmcnt(0)" ::: "memory");
        const float inv = 1.0f / sum; const float lse = mx + __logf(sum);
        if (has_next) att_qprep(qraw, lds, kq, qf, rq);
        bf16_t* op = OG + ((size_t)g * M + qrow) * 1024 + h * 128 + 4 * kq;
#pragma unroll
        for (int dt = 0; dt < 8; ++dt) { u32x2 o; o.x = pk2(oacc[dt][0] * inv, oacc[dt][1] * inv); o.y = pk2(oacc[dt][2] * inv, oacc[dt][3] * inv); *(u32x2*)(op + 16 * dt) = o; }
        if (kq == 0) LSE[((size_t)g * M + qrow) * 8 + h] = lse;
        if (!has_next) break;
        att_dma<1>(P, nxt, lds, w, lane);
        cur = nxt; it = itn;
    }
}
#undef ATT_BAR
__device__ __forceinline__ void phase_attn_merge(const Ctx& c, ArgsP a) {
    const bf16_t* OG = (const bf16_t*)(a->ws + WS_OG); const float* LSE = (const float*)(a->ws + WS_LSE); bf16_t* Y2 = (bf16_t*)(a->ws + WS_Y) + (size_t)2 * M * 1024;
    for (size_t i0 = c.gtid; i0 < (size_t)M * 128; i0 += (size_t)4 * c.NGT) {
        float l0[4], l1[4], l2[4]; u32x4 a0[4], a1[4], a2[4];
#pragma unroll
        for (int k = 0; k < 4; ++k) { const size_t i = i0 + (size_t)k * c.NGT; const size_t m = i >> 7; const int c8 = (int)(i & 127) * 8, h = c8 >> 7;
            l0[k] = LSE[m * 8 + h]; l1[k] = LSE[((size_t)M + m) * 8 + h]; l2[k] = LSE[((size_t)2 * M + m) * 8 + h];
            a0[k] = *(const u32x4*)(OG + m * 1024 + c8); a1[k] = *(const u32x4*)(OG + ((size_t)M + m) * 1024 + c8); a2[k] = *(const u32x4*)(OG + ((size_t)2 * M + m) * 1024 + c8); }
#pragma unroll
        for (int k = 0; k < 4; ++k) { const size_t i = i0 + (size_t)k * c.NGT; const size_t m = i >> 7; const int c8 = (int)(i & 127) * 8;
            const float mm = fmaxf(l0[k], fmaxf(l1[k], l2[k])); float e0 = __expf(l0[k] - mm), e1 = __expf(l1[k] - mm), e2 = __expf(l2[k] - mm); const float inv = 1.0f / (e0 + e1 + e2); e0 *= inv; e1 *= inv; e2 *= inv;
            u32x4 o;
#pragma unroll
            for (int e = 0; e < 4; ++e) o[e] = pk2(e0 * bflo(a0[k][e]) + e1 * bflo(a1[k][e]) + e2 * bflo(a2[k][e]), e0 * bfhi(a0[k][e]) + e1 * bfhi(a1[k][e]) + e2 * bfhi(a2[k][e]));
            *(u32x4*)(Y2 + m * 1024 + c8) = o; }
    }
}

constexpr int A1_XC32 = 0, A1_XCB = 32768, A1_A32 = 49152, A1_U32 = 83968, A1_SUM = 118784;
#define A1_BAR() do { asm volatile("s_waitcnt lgkmcnt(0)" ::: "memory"); __builtin_amdgcn_s_barrier(); asm volatile("" ::: "memory"); } while (0)
#define A1_WSYNC() asm volatile("s_waitcnt lgkmcnt(0)" ::: "memory")
__device__ __forceinline__ void phase_a1(const Ctx& c, ArgsP a, int l) {
    const bf16_t* P = (const bf16_t*)(a->ws + WS_PROJ); const bf16_t* WGT = (const bf16_t*)(a->ws + WS_WGT);
    bf16_t* HL = (bf16_t*)(a->ws + WS_HL); bf16_t* AC = (bf16_t*)(a->ws + WS_AC); float* CSA = (float*)(a->ws + WS_CSA); float* CSH = (float*)(a->ws + WS_CSH);
    const float* cw = a->in[9] + (size_t)l * 4 * 1024; const float* cb = a->in[10] + (size_t)l * 1024;
    const float* ba = a->in[12] + (size_t)l * 1024; const float* bx = a->in[14] + (size_t)l * 1024; const float* lam = a->in[15] + (size_t)l * 1024;
    LAS unsigned char* lds = c.lds; const int tid = c.tid, lane = c.lane, w = c.wave, n = lane & 15, kq = lane >> 4;
    LAS float* XC32 = (LAS float*)(lds + A1_XC32); LAS float* A32 = (LAS float*)(lds + A1_A32); LAS float* U32 = (LAS float*)(lds + A1_U32); LAS float* SUM0 = (LAS float*)(lds + A1_SUM);
    unsigned short xr[19];
#define A1_LOAD(IT) do { const int chunk_ = (IT) >> 4, h_ = (IT) & 15, row0_ = chunk_ * 128, tseq0_ = row0_ & (SEQ - 1), r0_ = (tid >> 6) * 16; \
        const bf16_t* xp_ = P + (size_t)(row0_ + r0_) * NIN + C_XA + h_ * 64 + (tid & 63); \
        _Pragma("unroll") for (int j = 0; j < 19; ++j) xr[j] = (tseq0_ + r0_ + j - 3 >= 0) ? xp_[(ptrdiff_t)(j - 3) * NIN] : (unsigned short)0; } while (0)
    if (c.bid < 2048) A1_LOAD(c.bid);
    bf16x8 wfa[4][2], wfx[4][2]; float cw0 = 0.f, cw1 = 0.f, cw2 = 0.f, cw3 = 0.f, cbb = 0.f, gba[4], gbx[4], gsp[4]; int hcur = -1;
#pragma unroll
    for (int nt = 0; nt < 4; ++nt) { gba[nt] = 0.f; gbx[nt] = 0.f; gsp[nt] = 0.f;
#pragma unroll
        for (int ks = 0; ks < 2; ++ks) { wfa[nt][ks] = (bf16x8){0, 0, 0, 0, 0, 0, 0, 0}; wfx[nt][ks] = (bf16x8){0, 0, 0, 0, 0, 0, 0, 0}; } }
    int par = 0;
    for (int it = c.bid; it < 2048; it += c.gdim, par ^= 1) {
        const int chunk = it >> 4, h = it & 15, row0 = chunk * 128, tseq0 = row0 & (SEQ - 1);
        LAS float* SUM = SUM0 + par * 1024;
        if (h != hcur) { hcur = h;
#pragma unroll
            for (int nt = 0; nt < 4; ++nt) {
#pragma unroll
                for (int ks = 0; ks < 2; ++ks) { wfa[nt][ks] = *(const bf16x8*)(WGT + ((size_t)h * 64 + 16 * nt + n) * 64 + 32 * ks + 8 * kq);
                                                 wfx[nt][ks] = *(const bf16x8*)(WGT + ((size_t)(16 + h) * 64 + 16 * nt + n) * 64 + 32 * ks + 8 * kq); }
                const int gch = h * 64 + 16 * nt + n; const float lm = lam[gch]; gba[nt] = ba[gch]; gbx[nt] = bx[gch];
                gsp[nt] = (lm > 0.f ? 0.f : -lm) + __logf(1.0f + __expf(-fabsf(lm)));
            }
            const int gch = h * 64 + (tid & 63); cw0 = cw[gch]; cw1 = cw[1024 + gch]; cw2 = cw[2048 + gch]; cw3 = cw[3072 + gch]; cbb = cb[gch];
        }
        {
            const int ch = tid & 63, rg = tid >> 6, r0 = rg * 16;
            const float w0 = cw0, w1 = cw1, w2 = cw2, w3 = cw3, bb = cbb;
            float xm1 = bf2f(xr[2]), xm2 = bf2f(xr[1]), xm3 = bf2f(xr[0]);
#pragma unroll
            for (int r = 0; r < 16; ++r) {
                const float x0 = bf2f(xr[3 + r]);
                const float y = bb + w0 * x0 + w1 * xm1 + w2 * xm2 + w3 * xm3;
                const int row = r0 + r;
                XC32[row * 64 + ch] = y;
                *(LAS bf16_t*)(lds + A1_XCB + row * 128 + ((((ch >> 3) ^ (row & 7))) << 4) + (ch & 7) * 2) = (bf16_t)f2bf(y);
                xm3 = xm2; xm2 = xm1; xm1 = x0;
            }
        }
        A1_WSYNC();
        if (it + c.gdim < 2048) A1_LOAD(it + c.gdim);
        {
            bf16x8 af[2];
#pragma unroll
            for (int ks = 0; ks < 2; ++ks) af[ks] = *(const LAS bf16x8*)(lds + A1_XCB + (16 * w + n) * 128 + (((4 * ks + kq) ^ (n & 7)) << 4));
#pragma unroll
            for (int nt = 0; nt < 4; ++nt) {
                f32x4 aa = (f32x4){0.f, 0.f, 0.f, 0.f}, ax = (f32x4){0.f, 0.f, 0.f, 0.f};
#pragma unroll
                for (int ks = 0; ks < 2; ++ks) {
                    aa = __builtin_amdgcn_mfma_f32_16x16x32_bf16(af[ks], wfa[nt][ks], aa, 0, 0, 0);
                    ax = __builtin_amdgcn_mfma_f32_16x16x32_bf16(af[ks], wfx[nt][ks], ax, 0, 0, 0);
                }
                const int ch = 16 * nt + n; const float ba_ = gba[nt], bx_ = gbx[nt], sp = gsp[nt];
#pragma unroll
                for (int e = 0; e < 4; ++e) {
                    const int row = 16 * w + 4 * kq + e;
                    const float r = pg8::sig_f(aa[e] + ba_), ig = pg8::sig_f(ax[e] + bx_);
                    const float log_a = -8.0f * r * sp, av = __expf(log_a), z2 = 2.0f * log_a;
                    const float om = (z2 > -0.05f) ? -z2 * (1.0f + z2 * (0.5f + z2 * (0.16666667f + z2 * 0.041666668f))) : 1.0f - av * av;
                    A32[row * 68 + ch] = av; U32[row * 68 + ch] = __builtin_sqrtf(om) * (ig * XC32[row * 64 + ch]);
                }
            }
        }
        A1_WSYNC();
        const int ch = tid & 63, seg = tid >> 6, gch = h * 64 + ch;
        {
            float hh = 0.f, AA = 1.f;
#pragma unroll
            for (int r = 0; r < 16; ++r) { const int o = (seg * 16 + r) * 68 + ch; const float av = A32[o], uv = U32[o]; hh = av * hh + uv; AA *= av; A32[o] = AA; U32[o] = hh; }
            SUM[(seg * 64 + ch) * 2] = AA; SUM[(seg * 64 + ch) * 2 + 1] = hh;
        }
        A1_BAR();
        {
            float cin = 0.f, Ain = 1.f;
            for (int s2 = 0; s2 < seg; ++s2) { const float As = SUM[(s2 * 64 + ch) * 2], Hs = SUM[(s2 * 64 + ch) * 2 + 1]; cin = As * cin + Hs; Ain *= As; }
            float hl = 0.f, ac = 1.f;
#pragma unroll
            for (int r = 0; r < 16; ++r) { const int o = (seg * 16 + r) * 68 + ch; hl = U32[o] + A32[o] * cin; ac = A32[o] * Ain;
                const size_t go = (size_t)(row0 + seg * 16 + r) * 1024 + gch; HL[go] = (bf16_t)f2bf(hl); AC[go] = (bf16_t)f2bf(ac); }
            if (seg == 7) { CSA[chunk * 1024 + gch] = ac; CSH[chunk * 1024 + gch] = hl; }
        }
    }
}
#undef A1_BAR
#undef A1_WSYNC
#undef A1_LOAD
__device__ __forceinline__ void phase_carry(const Ctx& c, ArgsP a) {
    const float* CSA = (const float*)(a->ws + WS_CSA); const float* CSH = (const float*)(a->ws + WS_CSH); float* CIN = (float*)(a->ws + WS_CIN);
    for (int w = c.gw; w < 2 * 1024; w += c.NGW) {
        const int b = w >> 10, gch = w & 1023, chunk = b * 64 + c.lane;
        float A = CSA[chunk * 1024 + gch], H = CSH[chunk * 1024 + gch];
#pragma unroll
        for (int o = 1; o < 64; o <<= 1) {
            const float Ap = __shfl_up(A, o), Hp = __shfl_up(H, o);
            if (c.lane >= o) { H = A * Hp + H; A = A * Ap; }
        }
        const float hin = __shfl_up(H, 1);
        CIN[chunk * 1024 + gch] = (c.lane == 0) ? 0.f : hin;
    }
}
__device__ __forceinline__ void phase_a3(const Ctx& c, ArgsP a) {
    const bf16_t* HL = (const bf16_t*)(a->ws + WS_HL); const bf16_t* AC = (const bf16_t*)(a->ws + WS_AC); const float* CIN = (const float*)(a->ws + WS_CIN);
    const bf16_t* P = (const bf16_t*)(a->ws + WS_PROJ); bf16_t* Y0 = (bf16_t*)(a->ws + WS_Y);
    for (int i = c.gtid; i < 128 * 8 * 128; i += c.NGT) {
        const int c8 = (i & 127) * 8, rg = (i >> 7) & 7, chunk = i >> 10;
        const f32x4 ca = *(const f32x4*)(CIN + chunk * 1024 + c8), cb = *(const f32x4*)(CIN + chunk * 1024 + c8 + 4);
#pragma unroll 1
        for (int r0 = 0; r0 < 16; r0 += 8) {
            u32x4 hl[8], ac[8], ga[8];
#pragma unroll
            for (int r = 0; r < 8; ++r) { const size_t row = (size_t)chunk * 128 + rg * 16 + r0 + r; hl[r] = *(const u32x4*)(HL + row * 1024 + c8); ac[r] = *(const u32x4*)(AC + row * 1024 + c8); ga[r] = *(const u32x4*)(P + row * NIN + C_GA + c8); }
#pragma unroll
            for (int r = 0; r < 8; ++r) { const size_t row = (size_t)chunk * 128 + rg * 16 + r0 + r; u32x4 o;
                o[0] = pk2((bflo(hl[r][0]) + bflo(ac[r][0]) * ca[0]) * bflo(ga[r][0]), (bfhi(hl[r][0]) + bfhi(ac[r][0]) * ca[1]) * bfhi(ga[r][0]));
                o[1] = pk2((bflo(hl[r][1]) + bflo(ac[r][1]) * ca[2]) * bflo(ga[r][1]), (bfhi(hl[r][1]) + bfhi(ac[r][1]) * ca[3]) * bfhi(ga[r][1]));
                o[2] = pk2((bflo(hl[r][2]) + bflo(ac[r][2]) * cb[0]) * bflo(ga[r][2]), (bfhi(hl[r][2]) + bfhi(ac[r][2]) * cb[1]) * bfhi(ga[r][2]));
                o[3] = pk2((bflo(hl[r][3]) + bflo(ac[r][3]) * cb[2]) * bflo(ga[r][3]), (bfhi(hl[r][3]) + bfhi(ac[r][3]) * cb[3]) * bfhi(ga[r][3]));
                *(u32x4*)(Y0 + row * 1024 + c8) = o; }
        }
    }
}

__device__ __forceinline__ void phase_pool(const Ctx& c, ArgsP a) {
    const bf16_t* P = (const bf16_t*)(a->ws + WS_PROJ); bf16_t* PL = (bf16_t*)(a->ws + WS_PL);
    for (int i = c.gtid; i < (M / 64) * 512; i += c.NGT) {
        const int blk = i >> 9, ch = (i & 511) * 2, win = 2 << (ch >> 8), row0 = blk * 64, tseq0 = row0 & (SEQ - 1); const float rwin = 1.0f / (float)win;
        const bf16_t* xp = P + (size_t)row0 * NIN + C_XB + ch;
        float ra[16], rb[16]; float sa = 0.f, sb = 0.f;
#pragma unroll
        for (int j = 0; j < 16; ++j) { const int back = 16 - j;
            unsigned w = 0u; if (back < win && tseq0 - back >= 0) w = *(const unsigned*)(xp - (ptrdiff_t)back * NIN);
            ra[j] = bflo(w); rb[j] = bfhi(w); sa += ra[j]; sb += rb[j]; }
#pragma unroll 1
        for (int r0 = 0; r0 < 64; r0 += 32) {
            unsigned w[32];
#pragma unroll
            for (int j = 0; j < 32; ++j) w[j] = *(const unsigned*)(xp + (size_t)(r0 + j) * NIN);
#pragma unroll
            for (int j = 0; j < 32; ++j) {
                const int r = r0 + j; const float xa = bflo(w[j]), xb = bfhi(w[j]);
                const float ta = sa + xa, tb = sb + xb; const int tq = tseq0 + r; const float rc = (tq + 1 < win) ? 1.0f / (float)(tq + 1) : rwin;
                *(unsigned*)(PL + (size_t)(row0 + r) * 1024 + ch) = pk2(ta * rc - xa, tb * rc - xb);
                const float da = (win == 2) ? ra[(j + 15) & 15] : (win == 4) ? ra[(j + 13) & 15] : (win == 8) ? ra[(j + 9) & 15] : ra[(j + 1) & 15];
                const float db = (win == 2) ? rb[(j + 15) & 15] : (win == 4) ? rb[(j + 13) & 15] : (win == 8) ? rb[(j + 9) & 15] : rb[(j + 1) & 15];
                sa = ta - da; sb = tb - db; ra[j & 15] = xa; rb[j & 15] = xb;
            }
        }
    }
}

#define SG_BAR() do { asm volatile("s_waitcnt lgkmcnt(0)" ::: "memory"); __builtin_amdgcn_s_barrier(); asm volatile("" ::: "memory"); } while (0)
__device__ __forceinline__ void phase_sg(const Ctx& c, ArgsP a, int l) {
    const bf16_t* P = (const bf16_t*)(a->ws + WS_PROJ); const bf16_t* WSB = (const bf16_t*)(a->ws + WS_WSB); const float* SSV = (const float*)(a->ws + WS_SSV);
    bf16_t* Y3 = (bf16_t*)(a->ws + WS_Y) + (size_t)3 * M * 1024;
    const float* sgn = a->in[20] + (size_t)l * 1024; const float* sgb = a->in[22] + (size_t)l * 8 * 128;
    LAS unsigned char* lds = c.lds; const int tid = c.tid, lane = c.lane, w = c.wave, n = lane & 15, kq = lane >> 4;
    if (c.bid >= 1024) return;
    const int sr = tid >> 2, sq = tid & 3;
    u32x4 zv[4]; f32x4 ssp[4]; u32x2 uu[8];
#define SG_LOAD(IT) do { const int row0_ = ((IT) >> 3) * 128, g_ = (IT) & 7; const size_t row_ = (size_t)row0_ + sr; \
        _Pragma("unroll") for (int i_ = 0; i_ < 4; ++i_) { ssp[i_] = *(const f32x4*)(SSV + row_ * 16 + 4 * i_); zv[i_] = *(const u32x4*)(P + row_ * NIN + C_ZV + g_ * 128 + (4 * sq + i_) * 8); } \
        _Pragma("unroll") for (int ct_ = 0; ct_ < 8; ++ct_) uu[ct_] = *(const u32x2*)(P + ((size_t)row0_ + 16 * w + n) * NIN + C_ZU + g_ * 128 + 16 * ct_ + 4 * kq); } while (0)
    SG_LOAD(c.bid);
    int gcur = -1; bf16x8 wfa[4]; f32x4 gn[4][2]; float bt = 0.f;
    for (int it = c.bid; it < 1024; it += c.gdim) {
        const int chunk = it >> 3, g = it & 7, row0 = chunk * 128;
        if (g != gcur) {
            gcur = g;
#pragma unroll
            for (int ks = 0; ks < 4; ++ks) wfa[ks] = *(const bf16x8*)(WSB + ((size_t)g * 128 + 16 * w + n) * 128 + 32 * ks + 8 * kq);
#pragma unroll
            for (int cc = 0; cc < 4; ++cc) { gn[cc][0] = *(const f32x4*)(sgn + g * 128 + (4 * sq + cc) * 8); gn[cc][1] = *(const f32x4*)(sgn + g * 128 + (4 * sq + cc) * 8 + 4); }
            bt = sgb[g * 128 + 16 * w + n];
        }
        {
            const float ss = (((ssp[0][0] + ssp[0][1]) + (ssp[0][2] + ssp[0][3])) + ((ssp[1][0] + ssp[1][1]) + (ssp[1][2] + ssp[1][3]))) + (((ssp[2][0] + ssp[2][1]) + (ssp[2][2] + ssp[2][3])) + ((ssp[3][0] + ssp[3][1]) + (ssp[3][2] + ssp[3][3])));
            const float rs = rsqrtf(ss * (1.0f / 1024.0f) + EPS);
#pragma unroll
            for (int cc = 0; cc < 4; ++cc) {
                const int chn = 4 * sq + cc;
                const u32x4 v = zv[cc]; const f32x4 g0 = gn[cc][0], g1 = gn[cc][1];
                u32x4 o; o[0] = pk2(bflo(v[0]) * rs * g0[0], bfhi(v[0]) * rs * g0[1]); o[1] = pk2(bflo(v[1]) * rs * g0[2], bfhi(v[1]) * rs * g0[3]);
                o[2] = pk2(bflo(v[2]) * rs * g1[0], bfhi(v[2]) * rs * g1[1]); o[3] = pk2(bflo(v[3]) * rs * g1[2], bfhi(v[3]) * rs * g1[3]);
                *(LAS u32x4*)(lds + sr * 256 + ((chn ^ ((sr & 7) << 1)) << 4)) = o;
            }
        }
        u32x2 ucur[8];
#pragma unroll
        for (int ct = 0; ct < 8; ++ct) ucur[ct] = uu[ct];
        SG_BAR();
        if (it + c.gdim < 1024) SG_LOAD(it + c.gdim);
        f32x4 acc[8];
#pragma unroll
        for (int ct = 0; ct < 8; ++ct) acc[ct] = (f32x4){0.f, 0.f, 0.f, 0.f};
        const int nks = (w >> 1) + 1;
#pragma unroll
        for (int ks = 0; ks < 4; ++ks) { if (ks >= nks) break;
            const bf16x8 wf = wfa[ks];
            const int sr0 = 32 * ks + 8 * kq + (n >> 2), sr1 = sr0 + 4;
#pragma unroll
            for (int ct = 0; ct < 8; ++ct) {
                const int chn = 2 * ct + ((lane & 3) >> 1);
                const s16x4 v0 = __builtin_amdgcn_ds_read_tr16_b64_v4i16((LAS s16x4*)(lds + sr0 * 256 + ((chn ^ ((sr0 & 7) << 1)) << 4) + (lane & 1) * 8));
                const s16x4 v1 = __builtin_amdgcn_ds_read_tr16_b64_v4i16((LAS s16x4*)(lds + sr1 * 256 + ((chn ^ ((sr1 & 7) << 1)) << 4) + (lane & 1) * 8));
                const bf16x8 vf = (bf16x8){v0[0], v0[1], v0[2], v0[3], v1[0], v1[1], v1[2], v1[3]};
                acc[ct] = __builtin_amdgcn_mfma_f32_16x16x32_bf16(vf, wf, acc[ct], 0, 0, 0);
            }
        }
        {
            const int t = 16 * w + n; const size_t row = (size_t)row0 + t;
#pragma unroll
            for (int ct = 0; ct < 8; ++ct) {
                const int col = g * 128 + 16 * ct + 4 * kq;
                u32x2 o; o.x = pk2(bflo(ucur[ct].x) * (acc[ct][0] + bt), bfhi(ucur[ct].x) * (acc[ct][1] + bt)); o.y = pk2(bflo(ucur[ct].y) * (acc[ct][2] + bt), bfhi(ucur[ct].y) * (acc[ct][3] + bt));
                *(u32x2*)(Y3 + row * 1024 + col) = o;
            }
        }
        SG_BAR();
    }
}
#undef SG_BAR
#undef SG_LOAD

#define XB_TMO      128
#define XB_XCNT(j)  (256  + 64 * (j))
#define XB_XSUB(j)  (1280 + 64 * (j))
#define XB_XGEN(j)  (2304 + 64 * (j))
#define XB_TOP      3328
#define XB_TOPGEN   3392
#define XCD_BAR_WORDS 3456
#define XB_SPIN_CAP (1u << 18)

__device__ __forceinline__ unsigned xb_ld(unsigned* p)              { return __hip_atomic_load(p, __ATOMIC_RELAXED, __HIP_MEMORY_SCOPE_AGENT); }
__device__ __forceinline__ unsigned xb_add(unsigned* p, unsigned v) { return __hip_atomic_fetch_add(p, v, __ATOMIC_RELAXED, __HIP_MEMORY_SCOPE_AGENT); }
__device__ __forceinline__ unsigned xb_xcc_id() { return (unsigned)__builtin_amdgcn_s_getreg((3 << 11) | 20) & 0xFu; }
#define XB_SPIN(cond, bar) do { unsigned _sp = 0; while (cond) { __builtin_amdgcn_s_sleep(1); \
    if ((++_sp & 255u) == 0u) { if (xb_ld(&(bar)[XB_TMO])) break; if (_sp > XB_SPIN_CAP) { atomicAdd(&(bar)[XB_TMO], 1u); break; } } } } while (0)

struct XcdBarrier {
    unsigned* bar; unsigned x;
    volatile LAS unsigned* st;
};

__device__ __forceinline__ XcdBarrier xcd_barrier_post(unsigned* bar, volatile LAS unsigned* st) {
    XcdBarrier b; b.bar = bar; b.x = xb_xcc_id(); b.st = st;
    if (threadIdx.x == 0) (void)xb_add(&bar[XB_XCNT(b.x)], 1u);
    return b;
}
__device__ __forceinline__ void xcd_barrier_complete(unsigned* bar, unsigned x, unsigned& nloc, unsigned& nx) {
    const unsigned G = gridDim.x * gridDim.y * gridDim.z;
    unsigned sum, cnt, mine, sp = 0u;
    for (;;) {
        sum = 0u; cnt = 0u; mine = 0u;
#pragma unroll
        for (unsigned j = 0; j < 16; ++j) { const unsigned c = xb_ld(&bar[XB_XCNT(j)]); sum += c; cnt += (c > 0u) ? 1u : 0u; mine = (j == x) ? c : mine; }
        if (sum == G) break;
        __builtin_amdgcn_s_sleep(1);
        if ((++sp & 255u) == 0u) { if (xb_ld(&bar[XB_TMO])) break; if (sp > XB_SPIN_CAP) { atomicAdd(&bar[XB_TMO], 1u); break; } }
    }
    nloc = mine > 0u ? mine : 1u; nx = cnt > 0u ? cnt : 1u;
}

__device__ __forceinline__ void xcd_barrier(const XcdBarrier& b) {
    asm volatile("s_waitcnt vmcnt(0)" ::: "memory");
    __syncthreads();
    if (threadIdx.x == 0) {
        unsigned* bar = b.bar;
        __builtin_amdgcn_s_waitcnt(0);
        unsigned nloc = b.st[0], nx = b.st[1];
        if (nloc == 0u) { xcd_barrier_complete(bar, b.x, nloc, nx); b.st[0] = nloc; b.st[1] = nx; }
        const unsigned old = xb_add(&bar[XB_XSUB(b.x)], 1u);
        const unsigned gen = old / nloc;
        if (old + 1u == (gen + 1u) * nloc) {
            __builtin_amdgcn_fence(__ATOMIC_RELEASE, "agent");
            asm volatile("s_waitcnt vmcnt(0)" ::: "memory");
            const unsigned og = xb_add(&bar[XB_TOP], 1u);
            const unsigned tg = og / nx;
            if (og + 1u == (tg + 1u) * nx) xb_add(&bar[XB_TOPGEN], 1u);
            else XB_SPIN(xb_ld(&bar[XB_TOPGEN]) == tg, bar);
            __builtin_amdgcn_fence(__ATOMIC_ACQUIRE, "agent");
            xb_add(&bar[XB_XGEN(b.x)], 1u);
            asm volatile("s_waitcnt vmcnt(0)" ::: "memory");
        } else {
            XB_SPIN(xb_ld(&bar[XB_XGEN(b.x)]) == gen, bar);
            __builtin_amdgcn_fence(__ATOMIC_ACQUIRE, "agent");
            asm volatile("s_waitcnt vmcnt(0)" ::: "memory");
        }
    }
    __syncthreads();
}

constexpr int LDS_BYTES = 147456;
constexpr int MISC_OFF = 131072 + 320;
constexpr int CW_BAR = 4096;
constexpr size_t CTL_ZERO_BYTES = 256 * 1024;

__global__ void __launch_bounds__(NTHR, 2) mk_fwd(Args args) {
    extern __shared__ __attribute__((aligned(16))) unsigned char lds_raw[];
    LAS unsigned char* const lds = (LAS unsigned char*)lds_raw;
    volatile LAS unsigned* MISC = (volatile LAS unsigned*)(lds + MISC_OFF);
    if (threadIdx.x < 32) MISC[threadIdx.x] = 0u;
    __syncthreads();
    (void)xcd_barrier_post((unsigned*)(args.ws + WS_CTL) + CW_BAR, MISC + 8);
    const ArgsP argp0 = (ArgsP)__builtin_amdgcn_kernarg_segment_ptr();
    const int s_lo = args.s_lo, s_hi = args.s_hi;
    int s = 0;
#define STEP_BEGIN if (s_lo <= s && s < s_hi) { \
    int tid_ = threadIdx.x, l_ = l; asm volatile("" : "+v"(tid_)); asm volatile("" : "+s"(l_)); ArgsP ap = argp0; asm volatile("" : "+s"(ap)); int bid_ = blockIdx.x, gdim_ = gridDim.x; asm volatile("" : "+s"(bid_)); asm volatile("" : "+s"(gdim_)); \
    Ctx c; c.lds = lds; c.tid = tid_; c.lane = tid_ & 63; c.wave = __builtin_amdgcn_readfirstlane(tid_ >> 6); \
    c.bid = bid_; c.gdim = gdim_; c.gw = bid_ * NWAVES + c.wave; c.NGW = gdim_ * NWAVES; c.gtid = bid_ * NTHR + c.tid; c.NGT = gdim_ * NTHR; \
    unsigned char* ws = ap->ws; float* X = ap->out; bf16_t* XN = (bf16_t*)(ws + ((l_ & 1) ? WS_XN2 : WS_XN)); bf16_t* XNnext = (bf16_t*)(ws + ((l_ & 1) ? WS_XN : WS_XN2)); unsigned char* XLO = ws + WS_XLO; \
    bf16_t* PROJ = (bf16_t*)(ws + WS_PROJ); bf16_t* H = (bf16_t*)(ws + WS_H); bf16_t* Y = (bf16_t*)(ws + WS_Y); \
    float* SS = (float*)(ws + WS_SS); \
    (void)X; (void)XN; (void)XNnext; (void)XLO; (void)PROJ; (void)H; (void)Y; (void)l_; (void)SS;
#define STEP_END   if (s + 1 < s_hi) { XcdBarrier bb; bb.bar = (unsigned*)(ap->ws + WS_CTL) + CW_BAR; asm volatile("" : "+s"(bb.bar)); bb.x = xb_xcc_id(); asm volatile("" : "+s"(bb.x)); \
        bb.st = (volatile LAS unsigned*)(lds + MISC_OFF) + 8; xcd_barrier(bb); } } ++s;

    for (int l = 0; l < NL; ++l) {
        STEP_BEGIN
            phase_prep(c, ap, l_);
            if (l_ == 0) phase_init(c, ap);
        STEP_END
        for (int f = 0; f < 2; ++f) {
            STEP_BEGIN
                pg8::Gemm g{XN, (const bf16_t*)(ws + (f ? WS_W13B : WS_W13A)), 0, 0, M, 2 * F, D, D, D, 1, 0, 0}; pg8::EpiUp E{H, SS + (size_t)(l_ * 4 + 2 * f) * M * 32};
                pg8::StaticOrder S; S.init(g.M, g.N, g.nS, gdim_, bid_);
                pg8::gemm_phase<pg8::EpiUp, pg8::StaticOrder>(c.lds, g, S, E);
            STEP_END
            STEP_BEGIN
                pg8::Gemm g{H, (const bf16_t*)(ws + (f ? WS_W2B : WS_W2A)), 0, 0, M, D, F, F, F, 1, 0, 0}; pg8::EpiRes E{XN, XN, XLO, nullptr, SS + (size_t)(l_ * 4 + 2 * f + 1) * M * 32, nullptr, nullptr, 0.5f, 0};
                pg8::StaticOrder S; S.init(g.M, g.N, g.nS, gdim_, bid_, 1);
                pg8::gemm_phase<pg8::EpiRes, pg8::StaticOrder>(c.lds, g, S, E);
            STEP_END
            if (f == 0) {
                STEP_BEGIN
                    pg8::Gemm g{XN, (const bf16_t*)(ws + WS_WIN), 0, 0, M, NIN, D, D, D, 1, 0, 0}; pg8::EpiIn E{PROJ, SS + (size_t)(l_ * 4 + 1) * M * 32, (float*)(ws + WS_SSV), ap->in[8] + (size_t)l_ * 4 * D};
                    pg8::StaticOrder S; S.init(g.M, g.N, g.nS, gdim_, bid_);
                    pg8::gemm_phase<pg8::EpiIn, pg8::StaticOrder>(c.lds, g, S, E);
                STEP_END
                STEP_BEGIN
                    phase_attn(c, ap, l_);
                    phase_sg(c, ap, l_);
                    phase_a1(c, ap, l_);
                    phase_pool(c, ap);
                STEP_END
                STEP_BEGIN
                    pg8::Gemm g{(const bf16_t*)(ws + WS_PL), (const bf16_t*)(ws + WS_WPOOL), 256, 256 * 256, M, 256, 256, 1024, 256, 4, 0, 0};
                    pg8::EpiPlain E{Y + (size_t)1 * M * 1024, 1024, 256};
                    pg8::StaticOrder S; S.init(g.M, g.N, g.nS, gdim_, bid_);
                    pg8::gemm_phase<pg8::EpiPlain, pg8::StaticOrder>(c.lds, g, S, E);
                    phase_carry(c, ap);
                STEP_END
                STEP_BEGIN
                    phase_a3(c, ap);
                    phase_attn_merge(c, ap);
                STEP_END
                STEP_BEGIN
                    pg8::Gemm g{Y, (const bf16_t*)(ws + WS_WBR), (size_t)M * 1024, (size_t)D * 1024, M, D, 1024, 1024, 1024, 1, 0, 0}; pg8::EpiBr E{PROJ + C_GATE, (bf16_t*)(ws + WS_MRGB)};
                    pg8::BrOrder S; S.so.init(g.M, g.N, 1, gdim_, bid_, 1);
                    pg8::gemm_phase<pg8::EpiBr, pg8::BrOrder>(c.lds, g, S, E);
                STEP_END
                STEP_BEGIN
                    pg8::Gemm g{(const bf16_t*)(ws + WS_MRGB), (const bf16_t*)(ws + WS_WOUT), 0, 0, M, D, D, D, D, 1, 0, 0}; pg8::EpiRes E{XN, XN, XLO, nullptr, SS + (size_t)(l_ * 4 + 2) * M * 32, nullptr, nullptr, 1.0f, 0};
                    pg8::StaticOrder S; S.init(g.M, g.N, g.nS, gdim_, bid_, 1);
                    pg8::gemm_phase<pg8::EpiRes, pg8::StaticOrder>(c.lds, g, S, E);
                STEP_END
            } else {
                STEP_BEGIN
                    const bf16_t* PB = (const bf16_t*)(ws + WS_PB); const bf16_t* WPP = (const bf16_t*)(ws + WS_WPP); const bf16_t* WPG = (const bf16_t*)(ws + WS_WPG);
                    pg8::Gemm g{PB, WPP, (size_t)(XN - PB), (size_t)(WPG - WPP), M, D, D, D, D, 1, PLE, 0};
                    pg8::EpiRes E{XN, XNnext, XLO, (l_ + 1 < NL) ? nullptr : X, (l_ + 1 < NL) ? SS + (size_t)((l_ + 1) * 4) * M * 32 : nullptr, SS + (size_t)(l_ * 4 + 3) * M * 32, (const bf16_t*)(ws + WS_PP), 0.f, 1};
                    pg8::PleOrder S; S.so.init(g.M, g.N, 1, gdim_, bid_, 1);
                    pg8::gemm_phase<pg8::EpiRes, pg8::PleOrder>(c.lds, g, S, E);
                STEP_END
            }
        }
    }
#undef STEP_BEGIN
#undef STEP_END
}

#ifndef MK_PER_STEP
#define MK_PER_STEP 0
#endif
constexpr int NSTEPS_TOTAL = NL * (1 + 2 + 4 + 1 + 1 + 2 + 1);
extern "C" void kernel_launch(void* const* d_in, const int* in_sizes, int n_in, void* d_out, int out_size, void* d_ws, size_t ws_size, hipStream_t stream) {
    static int grid = 0;
    if (grid == 0) {
        if (n_in != 32 || out_size != M * D || ws_size < WS_END) { fprintf(stderr, "kernel_launch: unexpected shapes: n_in %d out %d ws %zu (need %zu)\n", n_in, out_size, ws_size, (size_t)WS_END); grid = -1; return; }
        int dev = 0, cus = 0, per_cu = 0;
        if (hipGetDevice(&dev) != hipSuccess || hipDeviceGetAttribute(&cus, hipDeviceAttributeMultiprocessorCount, dev) != hipSuccess) { grid = -1; return; }
        if (hipFuncSetAttribute((const void*)mk_fwd, hipFuncAttributeMaxDynamicSharedMemorySize, LDS_BYTES) != hipSuccess) { fprintf(stderr, "kernel_launch: hipFuncSetAttribute failed\n"); grid = -1; return; }
        if (hipOccupancyMaxActiveBlocksPerMultiprocessor(&per_cu, (const void*)mk_fwd, NTHR, LDS_BYTES) != hipSuccess || per_cu < 1) { fprintf(stderr, "kernel_launch: occupancy query says %d blocks per CU\n", per_cu); (void)hipGetLastError(); }
        grid = cus;
    }
    if (grid < 0) return;
    if (hipMemsetAsync((char*)d_ws + WS_CTL, 0, CTL_ZERO_BYTES, stream) != hipSuccess) return;
    Args a{};
    for (int i = 0; i < 32; ++i) a.in[i] = (const float*)d_in[i];
    a.out = (float*)d_out; a.ws = (unsigned char*)d_ws;
#if MK_PER_STEP
    for (int s = 0; s < NSTEPS_TOTAL; ++s) { a.s_lo = s; a.s_hi = s + 1; hipLaunchKernelGGL(mk_fwd, dim3(grid), dim3(NTHR), LDS_BYTES, stream, a); }
#else
    a.s_lo = 0; a.s_hi = NSTEPS_TOTAL;
    hipLaunchKernelGGL(mk_fwd, dim3(grid), dim3(NTHR), LDS_BYTES, stream, a);
#endif
}
```
